# Optimizing an MI355X kernel written in HIP

```python
import math
import jax, jax.numpy as jnp
from jax import lax
import numpy as np

D_MODEL = 1024
BATCH = 16
SEQ = 2048
DEPTH = 2

CHUNK = 64
Q_BLOCK = 128
EPS = 1e-6

FOX_HEAD_DIM = 64
FOX_WIDTH = D_MODEL // 4
FOX_HEADS = FOX_WIDTH // FOX_HEAD_DIM
HGRN_KEY_DIM = 128
HGRN_WIDTH = D_MODEL // 2
HGRN_HEADS = HGRN_WIDTH // 128
HGRN_VAL_DIM = HGRN_WIDTH // HGRN_HEADS
HGRN_FORGET_DIM = HGRN_HEADS * HGRN_KEY_DIM
S5_WIDTH = D_MODEL // 4
S5_GROUP = 16
S5_GROUPS = S5_WIDTH // S5_GROUP
S5_STATE = 64

MIX_WIDTH = FOX_WIDTH + HGRN_WIDTH + S5_WIDTH
D_FF = 2816

IN_SIZES = [FOX_WIDTH, FOX_WIDTH, FOX_WIDTH, FOX_HEADS,
            HGRN_FORGET_DIM, HGRN_FORGET_DIM, HGRN_WIDTH, HGRN_WIDTH,
            S5_WIDTH]
IN_WIDTH = sum(IN_SIZES)
IN_SPLITS = [int(v) for v in np.cumsum(IN_SIZES)[:-1]]

kernel_name = "hybrid_fox_hgrn2_s5_macaron"


def rms_norm(x, gain):
    xf = x.astype(jnp.float32)
    y = xf * lax.rsqrt(jnp.mean(xf * xf, axis=-1, keepdims=True) + EPS)
    return (y * gain.astype(jnp.float32)).astype(x.dtype)


def swiglu(x, w_gate, w_up, w_down):
    return (jax.nn.silu(x @ w_gate) * (x @ w_up)) @ w_down


def fox_attention(q, k, v, f_logit):
    L = q.shape[1]
    scale = 1.0 / math.sqrt(q.shape[-1])
    c = jnp.cumsum(jax.nn.log_sigmoid(f_logit.astype(jnp.float32)), axis=1)
    c = c.transpose(0, 2, 1)
    qf = q.astype(jnp.float32).transpose(0, 2, 1, 3)
    kf = k.astype(jnp.float32).transpose(0, 2, 1, 3)
    vf = v.astype(jnp.float32).transpose(0, 2, 1, 3)
    outs = []
    for blk in range(L // Q_BLOCK):
        qs, qe = blk * Q_BLOCK, (blk + 1) * Q_BLOCK
        s = jnp.einsum('bhqd,bhkd->bhqk', qf[:, :, qs:qe], kf[:, :, :qe]) * scale
        s = s + c[:, :, qs:qe, None] - c[:, :, None, :qe]
        mask = jnp.arange(qs, qe)[:, None] >= jnp.arange(qe)[None, :]
        p = jax.nn.softmax(jnp.where(mask, s, -jnp.inf), axis=-1)
        outs.append(jnp.einsum('bhqk,bhkd->bhqd', p, vf[:, :, :qe]))
    return jnp.concatenate(outs, axis=2).transpose(0, 2, 1, 3)


def _to_chunks(t, n_chunks):
    b, _, h, d = t.shape
    return t.reshape(b, n_chunks, CHUNK, h, d).transpose(1, 0, 3, 2, 4)


def hgrn2(q, f_logit, i_in, lb):
    bsz, L, h, kd = q.shape
    vd = i_in.shape[-1]
    n = L // CHUNK
    f = lb + (1.0 - lb) * jax.nn.sigmoid(f_logit.astype(jnp.float32))
    log_f = jnp.log(f)
    key = 1.0 - f
    qc = _to_chunks(q.astype(jnp.float32), n)
    kc = _to_chunks(key, n)
    gc = _to_chunks(log_f, n)
    vc = _to_chunks(i_in.astype(jnp.float32), n)
    mask = (jnp.arange(CHUNK)[:, None] >= jnp.arange(CHUNK)[None, :])[None, None, :, :, None]

    def step(S, inp):
        q_c, k_c, g_c, v_c = inp
        b = jnp.cumsum(g_c, axis=2)
        diff = b[:, :, :, None, :] - b[:, :, None, :, :]
        decay = jnp.exp(jnp.where(mask, diff, -jnp.inf))
        attn = jnp.einsum('bhtk,bhsk,bhtsk->bhts', q_c, k_c, decay)
        o = jnp.einsum('bhts,bhsv->bhtv', attn, v_c)
        o = o + jnp.einsum('bhtk,bhkv->bhtv', q_c * jnp.exp(b), S)
        b_last = b[:, :, -1]
        S_new = jnp.exp(b_last)[..., None] * S + jnp.einsum(
            'bhsk,bhsv->bhkv', k_c * jnp.exp(b_last[:, :, None, :] - b), v_c)
        return S_new, o

    S0 = jnp.zeros((bsz, h, kd, vd), jnp.float32)
    _, o = lax.scan(step, S0, (qc, kc, gc, vc))
    return o.transpose(1, 0, 3, 2, 4).reshape(bsz, L, h, vd)


def _complex_scan_combine(e1, e2):
    a1r, a1i, b1r, b1i = e1
    a2r, a2i, b2r, b2i = e2
    ar = a1r * a2r - a1i * a2i
    ai = a1r * a2i + a1i * a2r
    br = a2r * b1r - a2i * b1i + b2r
    bi = a2r * b1i + a2i * b1r + b2i
    return (ar, ai, br, bi)


def s5_block(u, lam_re, lam_im, log_step, B_re, B_im, C_re, C_im, D, glu_w, glu_b):
    bsz, L, _ = u.shape
    uf = u.astype(jnp.float32).reshape(bsz, L, S5_GROUPS, S5_GROUP)
    lr = lam_re.astype(jnp.float32)
    li = lam_im.astype(jnp.float32)
    dt = jnp.exp(log_step.astype(jnp.float32))[:, None]
    mag = jnp.exp(lr * dt)
    lbar_re = mag * jnp.cos(li * dt)
    lbar_im = mag * jnp.sin(li * dt)
    nr, ni = lbar_re - 1.0, lbar_im
    den = lr * lr + li * li
    coef_re = (nr * lr + ni * li) / den
    coef_im = (ni * lr - nr * li) / den
    Br = B_re.astype(jnp.float32)
    Bi = B_im.astype(jnp.float32)
    bbar_re = coef_re[..., None] * Br - coef_im[..., None] * Bi
    bbar_im = coef_re[..., None] * Bi + coef_im[..., None] * Br
    bu_re = jnp.einsum('blgh,gph->blgp', uf, bbar_re)
    bu_im = jnp.einsum('blgh,gph->blgp', uf, bbar_im)
    a_re = jnp.broadcast_to(lbar_re, bu_re.shape)
    a_im = jnp.broadcast_to(lbar_im, bu_im.shape)
    _, _, x_re, x_im = lax.associative_scan(
        _complex_scan_combine, (a_re, a_im, bu_re, bu_im), axis=1)
    y = (jnp.einsum('blgp,ghp->blgh', x_re, C_re.astype(jnp.float32))
         - jnp.einsum('blgp,ghp->blgh', x_im, C_im.astype(jnp.float32))
         + D.astype(jnp.float32).reshape(S5_GROUPS, S5_GROUP) * uf)
    z = jax.nn.gelu(y.reshape(bsz, L, S5_WIDTH))
    return z * jax.nn.sigmoid(z @ glu_w.astype(jnp.float32) + glu_b.astype(jnp.float32))


def setup_inputs(seed: int = 0) -> dict:
    key = jax.random.key(seed)
    ks = jax.random.split(key, 32)
    f32 = jnp.float32

    def nrm(k, shape, scale):
        return jax.random.normal(k, shape, f32) * scale

    def gain(k, shape):
        return 1.0 + 0.02 * jax.random.normal(k, shape, f32)

    lam_im_base = jnp.pi * jnp.arange(S5_STATE, dtype=f32)
    log_lo, log_hi = math.log(0.001), math.log(0.1)
    return {
        "x": nrm(ks[0], (BATCH, SEQ, D_MODEL), 1.0),
        "ffn1_norm": gain(ks[1], (DEPTH, D_MODEL)),
        "ffn1_w_gate": nrm(ks[2], (DEPTH, D_MODEL, D_FF), D_MODEL ** -0.5),
        "ffn1_w_up": nrm(ks[3], (DEPTH, D_MODEL, D_FF), D_MODEL ** -0.5),
        "ffn1_w_down": nrm(ks[4], (DEPTH, D_FF, D_MODEL), D_FF ** -0.5),
        "mix_norm": gain(ks[5], (DEPTH, D_MODEL)),
        "w_in": nrm(ks[6], (DEPTH, D_MODEL, IN_WIDTH), D_MODEL ** -0.5),
        "fox_f_bias": nrm(ks[7], (DEPTH, FOX_HEADS), 0.1),
        "fox_q_gain": gain(ks[8], (DEPTH, FOX_HEAD_DIM)),
        "fox_k_gain": gain(ks[9], (DEPTH, FOX_HEAD_DIM)),
        "hgrn_lb": nrm(ks[10], (DEPTH, HGRN_FORGET_DIM), 0.1),
        "hgrn_o_gain": gain(ks[11], (DEPTH, HGRN_WIDTH)),
        "s5_lambda_re": -0.5 + nrm(ks[12], (DEPTH, S5_GROUPS, S5_STATE), 0.01),
        "s5_lambda_im": lam_im_base + nrm(ks[13], (DEPTH, S5_GROUPS, S5_STATE), 0.01),
        "s5_log_step": log_lo + (log_hi - log_lo) * jax.random.uniform(ks[14], (DEPTH, S5_GROUPS), f32),
        "s5_B_re": nrm(ks[15], (DEPTH, S5_GROUPS, S5_STATE, S5_GROUP), (2 * S5_GROUP) ** -0.5),
        "s5_B_im": nrm(ks[16], (DEPTH, S5_GROUPS, S5_STATE, S5_GROUP), (2 * S5_GROUP) ** -0.5),
        "s5_C_re": nrm(ks[17], (DEPTH, S5_GROUPS, S5_GROUP, S5_STATE), S5_STATE ** -0.5),
        "s5_C_im": nrm(ks[18], (DEPTH, S5_GROUPS, S5_GROUP, S5_STATE), S5_STATE ** -0.5),
        "s5_D": nrm(ks[19], (DEPTH, S5_WIDTH), 1.0),
        "s5_glu_w": nrm(ks[20], (DEPTH, S5_WIDTH, S5_WIDTH), S5_WIDTH ** -0.5),
        "s5_glu_b": nrm(ks[21], (DEPTH, S5_WIDTH), 0.02),
        "w_out": nrm(ks[22], (DEPTH, MIX_WIDTH, D_MODEL), MIX_WIDTH ** -0.5),
        "ffn2_norm": gain(ks[23], (DEPTH, D_MODEL)),
        "ffn2_w_gate": nrm(ks[24], (DEPTH, D_MODEL, D_FF), D_MODEL ** -0.5),
        "ffn2_w_up": nrm(ks[25], (DEPTH, D_MODEL, D_FF), D_MODEL ** -0.5),
        "ffn2_w_down": nrm(ks[26], (DEPTH, D_FF, D_MODEL), D_FF ** -0.5),
    }


def reference(x, ffn1_norm, ffn1_w_gate, ffn1_w_up, ffn1_w_down, mix_norm, w_in,
              fox_f_bias, fox_q_gain, fox_k_gain, hgrn_lb, hgrn_o_gain,
              s5_lambda_re, s5_lambda_im, s5_log_step, s5_B_re, s5_B_im, s5_C_re, s5_C_im,
              s5_D, s5_glu_w, s5_glu_b, w_out,
              ffn2_norm, ffn2_w_gate, ffn2_w_up, ffn2_w_down):
    bsz, L, _ = x.shape
    lb_all = jnp.cumsum(jax.nn.softmax(hgrn_lb.astype(jnp.float32), axis=0), axis=0)
    lb_all = lb_all - lb_all[0:1]
    for l in range(DEPTH):
        h = rms_norm(x, ffn1_norm[l])
        x = x + 0.5 * swiglu(h, ffn1_w_gate[l], ffn1_w_up[l], ffn1_w_down[l])

        h = rms_norm(x, mix_norm[l])
        p = h @ w_in[l]
        a_q, a_k, a_v, a_f, b_q, b_f, b_i, b_g, c_u = jnp.split(p, IN_SPLITS, axis=-1)

        q = rms_norm(a_q.reshape(bsz, L, FOX_HEADS, FOX_HEAD_DIM), fox_q_gain[l])
        k = rms_norm(a_k.reshape(bsz, L, FOX_HEADS, FOX_HEAD_DIM), fox_k_gain[l])
        v = a_v.reshape(bsz, L, FOX_HEADS, FOX_HEAD_DIM)
        o_a = fox_attention(q, k, v, a_f + fox_f_bias[l]).reshape(bsz, L, FOX_WIDTH)

        lb = lb_all[l].reshape(HGRN_HEADS, HGRN_KEY_DIM)
        o_b = hgrn2(b_q.reshape(bsz, L, HGRN_HEADS, HGRN_KEY_DIM),
                    b_f.reshape(bsz, L, HGRN_HEADS, HGRN_KEY_DIM),
                    b_i.reshape(bsz, L, HGRN_HEADS, HGRN_VAL_DIM), lb)
        o_b = rms_norm(o_b, hgrn_o_gain[l].reshape(HGRN_HEADS, HGRN_VAL_DIM))
        o_b = (o_b * jax.nn.silu(b_g.astype(jnp.float32).reshape(bsz, L, HGRN_HEADS, HGRN_VAL_DIM))
               ).reshape(bsz, L, HGRN_WIDTH)

        o_c = s5_block(c_u, s5_lambda_re[l], s5_lambda_im[l], s5_log_step[l],
                       s5_B_re[l], s5_B_im[l], s5_C_re[l], s5_C_im[l],
                       s5_D[l], s5_glu_w[l], s5_glu_b[l])

        mix = jnp.concatenate([o_a.astype(x.dtype), o_b.astype(x.dtype), o_c.astype(x.dtype)], axis=-1)
        x = x + mix @ w_out[l]

        h = rms_norm(x, ffn2_norm[l])
        x = x + 0.5 * swiglu(h, ffn2_w_gate[l], ffn2_w_up[l], ffn2_w_down[l])
    return x
```

```cpp
#include <hip/hip_runtime.h>
#include <cstdio>
#include <cstdint>
#include <cmath>
namespace pg8 {
#define PG8_LAS __attribute__((address_space(3)))
typedef unsigned short bf16_t;
typedef short bf16x8 __attribute__((ext_vector_type(8)));
typedef float f32x4 __attribute__((ext_vector_type(4)));
typedef unsigned u32x4 __attribute__((ext_vector_type(4)));
constexpr int BM = 256, BK = 64, HALF = 128, HTB = HALF * BK * 2  , STAGE_BYTES = 8 * HTB, NXCD = 8, WGM = 8;

__host__ __device__ __forceinline__ int lds_byte(int r, int c) { const int st = (r >> 4) * 2 + (c >> 5), rr = r & 15, cc = c & 31, ob = rr * 64 + cc * 2; return st * 1024 + (ob ^ (((ob >> 9) & 1) << 5)); }
__host__ __device__ __forceinline__ void stage_rc(int b, int& R, int& C) { const int st = b / 1024, sb = b % 1024, swz = sb ^ (((sb >> 9) & 1) << 5); R = (st >> 1) * 16 + swz / 64; C = (st & 1) * 32 + (swz % 64) / 2; }
__host__ __device__ __forceinline__ int perm32(int rho) { const int n = rho >> 4, i = rho & 15; return 8 * (i >> 2) + 4 * n + (i & 3); }

struct Unit { int pm, pn; };
struct Gemm { const bf16_t* A; const bf16_t* Bt; int M, N, K; };

struct StaticOrder {
    int nM, nN, nwg, G, c;
    __host__ __device__ void init(int M, int N, int G_, int c_) { nM = M / BM; nN = N / BM; nwg = nM * nN; G = G_; c = c_; }
    __host__ __device__ bool next(int i, Unit& u) const {
        const long L = (long)i * G + c; if (L >= nwg) return false;
        int wgid = (int)L; { const int q = nwg / NXCD, r = nwg % NXCD, xcd = wgid % NXCD, off = wgid / NXCD; wgid = (xcd < r ? xcd * (q + 1) : r * (q + 1) + (xcd - r) * q) + off; }
        const int nig = WGM * nN, gid = wgid / nig, fm = gid * WGM, gsz = (nM - fm) < WGM ? (nM - fm) : WGM;
        u.pm = fm + ((wgid % nig) % gsz); u.pn = (wgid % nig) / gsz; return true;
    }
    __device__ __forceinline__ void a_ready(const Unit&) const {}
    __device__ __forceinline__ void done(const Unit&) const {}
};


typedef float f32x2 __attribute__((ext_vector_type(2))); typedef __bf16 bf16x2_cv __attribute__((ext_vector_type(2)));
__device__ __forceinline__ unsigned cvt_pk_bf16(float lo, float hi) { const f32x2 v = {lo, hi}; return __builtin_bit_cast(unsigned, __builtin_convertvector(v, bf16x2_cv)); }
typedef unsigned u32x2 __attribute__((ext_vector_type(2)));
constexpr float RMS_EPS = 1e-6f;
typedef unsigned long long ssq_t;
constexpr float SSQ_SCALE = 16777216.0f, SSQ_INV = 1.0f / (16777216.0f * 1024.0f);
__device__ __forceinline__ float rstd_of(ssq_t s) { return __builtin_amdgcn_rsqf((float)s * SSQ_INV + RMS_EPS); }
__device__ __forceinline__ void prefetch_ssq(const ssq_t* ssq, const Unit& u, int par, PG8_LAS unsigned char* hi, int wid, int lane) {
    const ssq_t* src = ssq + (size_t)u.pm * BM + 128 * (lane >> 5) + 64 * (wid >> 2) + 2 * (lane & 31);
    __builtin_amdgcn_global_load_lds((const unsigned*)src, (PG8_LAS unsigned*)(hi + (par * 8 + wid) * 1024), 16, 0, 0);
}
#define PG8_RSTD8(r8, slot, fr) float r8[2][4]; { _Pragma("unroll") for (int ai_ = 0; ai_ < 2; ++ai_) _Pragma("unroll") for (int m_ = 0; m_ < 4; ++m_) r8[ai_][m_] = rstd_of(*(const PG8_LAS ssq_t*)((slot) + (64 * ai_ + 16 * m_ + (fr)) * 8)); }
__device__ __forceinline__ float silu_f(float g) { return g * __builtin_amdgcn_rcpf(1.0f + __builtin_amdgcn_exp2f(-1.4426950408889634f * g)); }
__device__ __forceinline__ float sigmoid_f(float g) { return __builtin_amdgcn_rcpf(1.0f + __builtin_amdgcn_exp2f(-1.4426950408889634f * g)); }

struct EpiSwiglu {
    static constexpr bool PERM = true, AFTER_DRAIN = false;
    bf16_t* O; const ssq_t* ssq;
    __device__ __forceinline__ void prefetch(const Unit& u, int par, PG8_LAS unsigned char* hi, int wid, int lane) const { prefetch_ssq(ssq, u, par, hi, wid, lane); }
    __device__ __forceinline__ void operator()(const f32x4 (&acc)[2][2][4][2], const Unit& u, int wr, int wc, int fr_, int fq_, const PG8_LAS unsigned char* slot) const {
        int fr = fr_, fq = fq_; asm volatile("" : "+v"(fr), "+v"(fq));
        const int row0 = u.pm * BM + wr * 64 + fr, col0 = u.pn * 128 + wc * 32 + 8 * fq;
        PG8_RSTD8(r8, slot, fr);
#pragma unroll
        for (int ai = 0; ai < 2; ++ai)
#pragma unroll
            for (int m = 0; m < 4; ++m) { const int row = row0 + ai * HALF + m * 16; const float r = r8[ai][m];
                u32x4 w; unsigned ww[4];
                const float rl = -1.4426950408889634f * r, rr = r * r;
#pragma unroll
                for (int n = 0; n < 2; ++n) { const f32x4 G = acc[ai][0][m][n], gu = G * acc[ai][1][m][n] * rr; float o4[4];
#pragma unroll
                    for (int i = 0; i < 4; ++i) o4[i] = gu[i] * __builtin_amdgcn_rcpf(1.0f + __builtin_amdgcn_exp2f(G[i] * rl));
                    ww[2 * n] = cvt_pk_bf16(o4[0], o4[1]); ww[2 * n + 1] = cvt_pk_bf16(o4[2], o4[3]); }
                w.x = ww[0]; w.y = ww[1]; w.z = ww[2]; w.w = ww[3];
                *(u32x4*)(O + (size_t)row * 2816 + col0) = w; }
    }
};

struct EpiResid {
    static constexpr bool PERM = true, AFTER_DRAIN = false;
    bf16_t* xb; float* outf; ssq_t* ssq; float alpha;
    __device__ __forceinline__ void prefetch(const Unit&, int, PG8_LAS unsigned char*, int, int) const {}
    __device__ __forceinline__ void operator()(const f32x4 (&acc)[2][2][4][2], const Unit& u, int wr, int wc, int fr_, int fq_, const PG8_LAS unsigned char* slot) const {
        int fr = fr_, fq = fq_; asm volatile("" : "+v"(fr), "+v"(fq));
        const int row0 = u.pm * BM + wr * 64 + fr, col0 = u.pn * BM + wc * 32 + 8 * fq;
#pragma unroll
        for (int ai = 0; ai < 2; ++ai) {
            u32x4 rv[4][2];
#pragma unroll
            for (int m = 0; m < 4; ++m)
#pragma unroll
                for (int bj = 0; bj < 2; ++bj) rv[m][bj] = *(const u32x4*)(xb + (size_t)(row0 + ai * HALF + m * 16) * 1024 + col0 + bj * HALF);
#pragma unroll
            for (int m = 0; m < 4; ++m) { const int row = row0 + ai * HALF + m * 16; const size_t off = (size_t)row * 1024 + col0; float ss = 0.f;
#pragma unroll
                for (int bj = 0; bj < 2; ++bj) { const u32x4 r4 = rv[m][bj];
                    const f32x4 o0 = (f32x4){__uint_as_float(r4.x << 16), __uint_as_float(r4.x & 0xffff0000u), __uint_as_float(r4.y << 16), __uint_as_float(r4.y & 0xffff0000u)} + acc[ai][bj][m][0] * alpha;
                    const f32x4 o1 = (f32x4){__uint_as_float(r4.z << 16), __uint_as_float(r4.z & 0xffff0000u), __uint_as_float(r4.w << 16), __uint_as_float(r4.w & 0xffff0000u)} + acc[ai][bj][m][1] * alpha;
                    ss += ((o0[0] * o0[0] + o0[1] * o0[1]) + (o0[2] * o0[2] + o0[3] * o0[3])) + ((o1[0] * o1[0] + o1[1] * o1[1]) + (o1[2] * o1[2] + o1[3] * o1[3]));
                    if (outf) { *(f32x4*)(outf + off + bj * HALF) = o0; *(f32x4*)(outf + off + bj * HALF + 4) = o1; }
                    else { u32x4 w; w.x = cvt_pk_bf16(o0[0], o0[1]); w.y = cvt_pk_bf16(o0[2], o0[3]); w.z = cvt_pk_bf16(o1[0], o1[1]); w.w = cvt_pk_bf16(o1[2], o1[3]); *(u32x4*)(xb + off + bj * HALF) = w; } }
                ss += __shfl_xor(ss, 16); ss += __shfl_xor(ss, 32);
                if (fq == 0 && !outf) __hip_atomic_fetch_add(ssq + row, (ssq_t)(ss * SSQ_SCALE), __ATOMIC_RELAXED, __HIP_MEMORY_SCOPE_AGENT); }
            asm volatile("" ::: "memory"); }
    }
};

struct EpiWin {
    static constexpr bool PERM = true, AFTER_DRAIN = false;
    unsigned char* R; const ssq_t* ssq; const float* qg; const float* kg; float* af; const float* lbt; const float* ogn;
    static constexpr size_t MiB = 1u << 20;
    __device__ __forceinline__ void prefetch(const Unit& u, int par, PG8_LAS unsigned char* hi, int wid, int lane) const { prefetch_ssq(ssq, u, par, hi, wid, lane); }
    static constexpr size_t O_Q = 0, O_K = 16 * MiB, O_V = 32 * MiB, O_HQ = 48 * MiB, O_HF = 80 * MiB, O_HI = 144 * MiB, O_HG = 176 * MiB, O_SU = 208 * MiB;
    __device__ __forceinline__ void operator()(const f32x4 (&acc)[2][2][4][2], const Unit& u, int wr, int wc, int fr_, int fq_, const PG8_LAS unsigned char* slot) const {
        int fr = fr_, fq = fq_; asm volatile("" : "+v"(fr), "+v"(fq));
        const int row0 = u.pm * BM + wr * 64 + fr; const int pn = u.pn;
        PG8_RSTD8(r8, slot, fr);
        if (pn < 2) {
            bf16_t* dst = (bf16_t*)(R + (pn == 0 ? O_Q : O_K)); const float* gn = pn == 0 ? qg : kg; const float sc = pn == 0 ? 0.125f * 1.4426950408889634f : 1.0f;
            f32x4 gv[2][2];
#pragma unroll
            for (int bj = 0; bj < 2; ++bj)
#pragma unroll
                for (int n = 0; n < 2; ++n) gv[bj][n] = *(const f32x4*)(gn + 32 * bj + 8 * fq + 4 * n) * sc;
#pragma unroll
            for (int ai = 0; ai < 2; ++ai)
#pragma unroll
                for (int m = 0; m < 4; ++m) { const int row = row0 + ai * HALF + m * 16; const float r = r8[ai][m]; float ss = 0.f; f32x4 v[2][2];
#pragma unroll
                    for (int bj = 0; bj < 2; ++bj)
#pragma unroll
                        for (int n = 0; n < 2; ++n) { v[bj][n] = acc[ai][bj][m][n] * r; const f32x4 x = v[bj][n]; ss += (x[0] * x[0] + x[1] * x[1]) + (x[2] * x[2] + x[3] * x[3]); }
                    ss += __shfl_xor(ss, 16); ss += __shfl_xor(ss, 32);
                    const float hr = __builtin_amdgcn_rsqf(ss * (1.0f / 64.0f) + RMS_EPS);
#pragma unroll
                    for (int bj = 0; bj < 2; ++bj) { const f32x4 a = v[bj][0] * hr * gv[bj][0], b = v[bj][1] * hr * gv[bj][1];
                        u32x4 w; w.x = cvt_pk_bf16(a[0], a[1]); w.y = cvt_pk_bf16(a[2], a[3]); w.z = cvt_pk_bf16(b[0], b[1]); w.w = cvt_pk_bf16(b[2], b[3]);
                        *(u32x4*)(dst + (size_t)row * 256 + 64 * wc + 32 * bj + 8 * fq) = w; } asm volatile("" ::: "memory"); }
        } else if (pn == 12) {
            if (wc == 0 && fq == 0) {
#pragma unroll
                for (int ai = 0; ai < 2; ++ai)
#pragma unroll
                    for (int m = 0; m < 4; ++m) { const int row = row0 + ai * HALF + m * 16; const float r = r8[ai][m]; *(f32x4*)(af + (size_t)row * 4) = acc[ai][0][m][0] * r; asm volatile("" ::: "memory"); } }
        } else if (pn == 5 || pn == 6) {
            float* dst = (float*)(R + O_HF) + (pn - 5) * 256 + wc * 32 + 8 * fq;
            f32x4 lb4[2][2];
#pragma unroll
            for (int bj = 0; bj < 2; ++bj)
#pragma unroll
                for (int n = 0; n < 2; ++n) lb4[bj][n] = *(const f32x4*)(lbt + (pn - 5) * 256 + wc * 32 + 8 * fq + bj * HALF + 4 * n);
#pragma unroll
            for (int ai = 0; ai < 2; ++ai)
#pragma unroll
                for (int m = 0; m < 4; ++m) { const int row = row0 + ai * HALF + m * 16; const float r = r8[ai][m];
#pragma unroll
                    for (int bj = 0; bj < 2; ++bj)
#pragma unroll
                        for (int n = 0; n < 2; ++n) { const f32x4 x = acc[ai][bj][m][n] * r; const f32x4 lb = lb4[bj][n]; f32x4 g;
#pragma unroll
                            for (int i = 0; i < 4; ++i) g[i] = lb[i] + (1.0f - lb[i]) * sigmoid_f(x[i]);
                            *(f32x4*)(dst + (size_t)row * 512 + bj * HALF + 4 * n) = g; } asm volatile("" ::: "memory"); }
        } else {
            size_t ob; int pitch, cb;
            if (pn == 2) { ob = O_V; pitch = 256; cb = 0; } else if (pn <= 4) { ob = O_HQ; pitch = 512; cb = (pn - 3) * 256; } else if (pn <= 8) { ob = O_HI; pitch = 512; cb = (pn - 7) * 256; }
            else if (pn <= 10) { ob = O_HG; pitch = 512; cb = (pn - 9) * 256; } else { ob = O_SU; pitch = 16; cb = 0; }
            bf16_t* dst = (bf16_t*)(R + ob) + cb + wc * 32 + 8 * fq;
            if (pn == 11) dst = (bf16_t*)(R + ob) + (size_t)(2 * wc + (fq >> 1)) * ((size_t)32768 * 16) + 8 * (fq & 1);
#pragma unroll
            for (int ai = 0; ai < 2; ++ai)
#pragma unroll
                for (int m = 0; m < 4; ++m) { const int row = row0 + ai * HALF + m * 16; const float r = r8[ai][m];
#pragma unroll
                    for (int bj = 0; bj < 2; ++bj) { f32x4 a = acc[ai][bj][m][0] * r, b = acc[ai][bj][m][1] * r;
                        if (pn == 9 || pn == 10) {
                            const f32x4 ga = *(const f32x4*)(ogn + (pn - 9) * 256 + wc * 32 + 8 * fq + bj * HALF), gb = *(const f32x4*)(ogn + (pn - 9) * 256 + wc * 32 + 8 * fq + bj * HALF + 4);
#pragma unroll
                            for (int i = 0; i < 4; ++i) { a[i] = silu_f(a[i]) * ga[i]; b[i] = silu_f(b[i]) * gb[i]; } }
                        u32x4 w; w.x = cvt_pk_bf16(a[0], a[1]); w.y = cvt_pk_bf16(a[2], a[3]); w.z = cvt_pk_bf16(b[0], b[1]); w.w = cvt_pk_bf16(b[2], b[3]);
                        *(u32x4*)(dst + (size_t)row * pitch + (pn == 11 ? (size_t)bj * 8 * ((size_t)32768 * 16) : (size_t)(bj * HALF))) = w; } asm volatile("" ::: "memory"); }
        }
    }
};

struct EpiGlu {
    static constexpr bool PERM = true, AFTER_DRAIN = false;
    const bf16_t* z; const float* b; bf16_t* mix;
    __device__ __forceinline__ void prefetch(const Unit&, int, PG8_LAS unsigned char*, int, int) const {}
    __device__ __forceinline__ void operator()(const f32x4 (&acc)[2][2][4][2], const Unit& u, int wr, int wc, int fr_, int fq_, const PG8_LAS unsigned char* slot) const {
        int fr = fr_, fq = fq_; asm volatile("" : "+v"(fr), "+v"(fq));
        const int row0 = u.pm * BM + wr * 64 + fr, col0 = u.pn * BM + wc * 32 + 8 * fq;
        f32x4 bv[2][2];
#pragma unroll
        for (int bj = 0; bj < 2; ++bj)
#pragma unroll
            for (int n = 0; n < 2; ++n) bv[bj][n] = *(const f32x4*)(b + col0 + bj * HALF + 4 * n);
#pragma unroll
        for (int ai = 0; ai < 2; ++ai)
#pragma unroll
            for (int m = 0; m < 4; ++m) { const int row = row0 + ai * HALF + m * 16;
#pragma unroll
                for (int bj = 0; bj < 2; ++bj) { const u32x4 zz = *(const u32x4*)(z + (size_t)row * 256 + col0 + bj * HALF);
                    const f32x4 a = acc[ai][bj][m][0] + bv[bj][0], c = acc[ai][bj][m][1] + bv[bj][1];
                    const float z0 = __uint_as_float(zz.x << 16), z1 = __uint_as_float(zz.x & 0xffff0000u), z2 = __uint_as_float(zz.y << 16), z3 = __uint_as_float(zz.y & 0xffff0000u);
                    const float z4 = __uint_as_float(zz.z << 16), z5 = __uint_as_float(zz.z & 0xffff0000u), z6 = __uint_as_float(zz.w << 16), z7 = __uint_as_float(zz.w & 0xffff0000u);
                    u32x4 w; w.x = cvt_pk_bf16(z0 * sigmoid_f(a[0]), z1 * sigmoid_f(a[1])); w.y = cvt_pk_bf16(z2 * sigmoid_f(a[2]), z3 * sigmoid_f(a[3]));
                    w.z = cvt_pk_bf16(z4 * sigmoid_f(c[0]), z5 * sigmoid_f(c[1])); w.w = cvt_pk_bf16(z6 * sigmoid_f(c[2]), z7 * sigmoid_f(c[3]));
                    *(u32x4*)(mix + (size_t)row * 1024 + 768 + col0 + bj * HALF) = w; asm volatile("" ::: "memory"); } }
    }
};
template <class Epi, class Sched, bool ALIGN_EPI = false, bool SP2 = false>
__device__ __forceinline__ void gemm_phase(PG8_LAS unsigned char* lds, const Gemm g, const Sched& S, const Epi& E) {
    int tid_ = threadIdx.x; asm volatile("" : "+v"(tid_));
    const int tid = tid_, wid = __builtin_amdgcn_readfirstlane(tid >> 6), lane = tid & 63, wr = wid >> 2, wc = wid & 3, fr = lane & 15, fq = lane >> 4;
    int K_ = g.K; asm volatile("" : "+s"(K_));
    const int K = K_, nt = K / BK;
    unsigned voffA[2], voffB[2];
#pragma unroll
    for (int i = 0; i < 2; ++i) { int R, C; stage_rc(tid * 16 + i * 8192, R, C); const int Rb = Epi::PERM ? ((R & ~31) + perm32(R & 31)) : R;
        voffA[i] = (unsigned)(R * K + C) * 2u; voffB[i] = (unsigned)(Rb * K + C) * 2u; }
    const size_t kstep = (size_t)(BK * 2);
    const size_t hstep = (size_t)HALF * K * 2;
    const size_t tstep = 2 * hstep;
    const unsigned ldsw = (unsigned)wid * 1024u;
    const int aoff = lds_byte(wr * 64 + fr, fq * 8), boff = lds_byte(wc * 32 + fr, fq * 8);
#define PG8_SA(b, h) (((b) * 2 + (h)) * HTB)
#define PG8_SB(b, h) ((4 + (b) * 2 + (h)) * HTB)
#define PG8_STAGE(bufoff, gbase, voff) do { _Pragma("unroll") for (int _i = 0; _i < 2; ++_i) \
        __builtin_amdgcn_global_load_lds((const unsigned*)((const char*)(gbase) + (voff)[_i]), (PG8_LAS unsigned*)(lds + (bufoff) + ldsw + _i * 8192), 16, 0, 0); } while (0)
#define PG8_LDA(dst, b, h) do { _Pragma("unroll") for (int m = 0; m < 4; ++m) _Pragma("unroll") for (int k = 0; k < 2; ++k) dst[m][k] = *(const PG8_LAS bf16x8*)(lds + PG8_SA(b, h) + aoff + m * 2048 + k * 1024); } while (0)
#define PG8_LDB(dst, b, h) do { _Pragma("unroll") for (int n = 0; n < 2; ++n) _Pragma("unroll") for (int k = 0; k < 2; ++k) dst[n][k] = *(const PG8_LAS bf16x8*)(lds + PG8_SB(b, h) + boff + n * 2048 + k * 1024); } while (0)
#define PG8_MMA(ai, bj, At, Bt) do { __builtin_amdgcn_s_setprio(1); _Pragma("unroll") for (int m = 0; m < 4; ++m) _Pragma("unroll") for (int n = 0; n < 2; ++n) _Pragma("unroll") for (int k = 0; k < 2; ++k) \
        acc[ai][bj][m][n] = __builtin_amdgcn_mfma_f32_16x16x32_bf16(Bt[n][k], At[m][k], acc[ai][bj][m][n], 0, 0, 0); __builtin_amdgcn_s_setprio(0); } while (0)
#define PG8_WAIT_V(n) asm volatile("s_waitcnt vmcnt(" #n ")" ::: "memory")
#define PG8_WAIT_L(n) asm volatile("s_waitcnt lgkmcnt(" #n ")" ::: "memory")
#define PG8_BAR __builtin_amdgcn_s_barrier()
#define PG8_SCHED __builtin_amdgcn_sched_barrier(0)
    Unit cur, nxt; int ui = 0;
    if (!S.next(0, cur)) return;
    f32x4 acc[2][2][4][2];
    float zf_ = 0.f; asm volatile("" : "+v"(zf_));
#pragma unroll
    for (int a = 0; a < 2; ++a)
#pragma unroll
        for (int b = 0; b < 2; ++b)
#pragma unroll
            for (int m = 0; m < 4; ++m)
#pragma unroll
                for (int n = 0; n < 2; ++n) acc[a][b][m][n] = (f32x4){zf_, zf_, zf_, zf_};
    bf16x8 At[4][2], B0[2][2], B1[2][2];
    const char* cA = (const char*)g.A + (size_t)cur.pm * tstep; const char* cB = (const char*)g.Bt + (size_t)cur.pn * tstep;
    S.a_ready(cur);
    E.prefetch(cur, 0, lds + STAGE_BYTES, wid, lane);
    if constexpr (SP2) {
        PG8_STAGE(PG8_SB(0, 0), cB, voffB); PG8_STAGE(PG8_SB(0, 1), cB + hstep, voffB); PG8_STAGE(PG8_SA(0, 0), cA, voffA); PG8_STAGE(PG8_SA(0, 1), cA + hstep, voffA);
        if (wr == 1) PG8_BAR;
        PG8_WAIT_V(2); PG8_BAR;
        PG8_STAGE(PG8_SB(1, 0), cB + kstep, voffB); PG8_STAGE(PG8_SA(1, 0), cA + kstep, voffA); PG8_STAGE(PG8_SB(1, 1), cB + hstep + kstep, voffB);
        PG8_WAIT_V(6); PG8_BAR;
    } else {
        PG8_STAGE(PG8_SB(0, 0), cB, voffB); PG8_STAGE(PG8_SA(0, 0), cA, voffA); PG8_STAGE(PG8_SB(0, 1), cB + hstep, voffB); PG8_STAGE(PG8_SA(0, 1), cA + hstep, voffA);
        if (wr == 1) PG8_BAR;
        PG8_WAIT_V(4); PG8_BAR;
        PG8_STAGE(PG8_SB(1, 0), cB + kstep, voffB); PG8_STAGE(PG8_SA(1, 0), cA + kstep, voffA); PG8_STAGE(PG8_SB(1, 1), cB + hstep + kstep, voffB);
        PG8_WAIT_V(6); PG8_BAR;
    }
    for (;;) {
        const bool has_next = S.next(ui + 1, nxt);
        const char* nA = has_next ? (const char*)g.A + (size_t)nxt.pm * tstep : cA; const char* nB = has_next ? (const char*)g.Bt + (size_t)nxt.pn * tstep : cB;
        for (int t = 0; t < nt; t += 2) {
            const bool last = (t == nt - 2);
            const char* a1 = cA + (size_t)(t + 1) * kstep;
            const char* a2 = last ? nA : cA + (size_t)(t + 2) * kstep; const char* b2 = last ? nB : cB + (size_t)(t + 2) * kstep;
            const char* a3 = a2 + kstep; const char* b3 = b2 + kstep;
            if (last && has_next) { S.a_ready(nxt); E.prefetch(nxt, (ui + 1) & 1, lds + STAGE_BYTES, wid, lane); }
            if constexpr (SP2) {
            PG8_LDB(B0, 0, 0); PG8_LDB(B1, 0, 1); PG8_SCHED; PG8_LDA(At, 0, 0); PG8_STAGE(PG8_SA(1, 1), a1 + hstep, voffA);
            PG8_WAIT_V(8); PG8_WAIT_L(0); PG8_BAR; PG8_MMA(0, 0, At, B0); PG8_MMA(0, 1, At, B1); PG8_BAR; PG8_SCHED;
            PG8_LDA(At, 0, 1); PG8_STAGE(PG8_SB(0, 0), b2, voffB); PG8_STAGE(PG8_SB(0, 1), b2 + hstep, voffB); PG8_STAGE(PG8_SA(0, 0), a2, voffA);
            PG8_WAIT_V(8); PG8_WAIT_L(0); PG8_BAR; PG8_MMA(1, 0, At, B0); PG8_MMA(1, 1, At, B1); PG8_BAR; PG8_SCHED;
            PG8_LDB(B0, 1, 0); PG8_LDB(B1, 1, 1); PG8_SCHED; PG8_LDA(At, 1, 0); PG8_STAGE(PG8_SA(0, 1), a2 + hstep, voffA);
            PG8_WAIT_V(8); PG8_WAIT_L(0); PG8_BAR; PG8_MMA(0, 0, At, B0); PG8_MMA(0, 1, At, B1); PG8_BAR; PG8_SCHED;
            PG8_LDA(At, 1, 1); PG8_STAGE(PG8_SB(1, 0), b3, voffB); PG8_STAGE(PG8_SB(1, 1), b3 + hstep, voffB); PG8_STAGE(PG8_SA(1, 0), a3, voffA);
            PG8_WAIT_V(8); PG8_WAIT_L(0); PG8_BAR; PG8_MMA(1, 0, At, B0); PG8_MMA(1, 1, At, B1); PG8_BAR; PG8_SCHED;
            } else {
            PG8_LDB(B0, 0, 0); PG8_SCHED; PG8_LDA(At, 0, 0); PG8_STAGE(PG8_SA(1, 1), a1 + hstep, voffA);
            PG8_WAIT_L(8); PG8_BAR; PG8_WAIT_L(0); PG8_MMA(0, 0, At, B0); PG8_BAR; PG8_SCHED;
            PG8_LDB(B1, 0, 1); PG8_STAGE(PG8_SB(0, 0), b2, voffB);
            PG8_BAR; PG8_WAIT_L(0); PG8_MMA(0, 1, At, B1); PG8_BAR;
            PG8_LDA(At, 0, 1); PG8_STAGE(PG8_SA(0, 0), a2, voffA);
            PG8_BAR; PG8_WAIT_L(0); PG8_MMA(1, 0, At, B0); PG8_BAR; PG8_SCHED;
            PG8_STAGE(PG8_SB(0, 1), b2 + hstep, voffB);
            PG8_WAIT_V(6); PG8_BAR; PG8_MMA(1, 1, At, B1); PG8_BAR;
            PG8_LDB(B0, 1, 0); PG8_SCHED; PG8_LDA(At, 1, 0); PG8_STAGE(PG8_SA(0, 1), a2 + hstep, voffA);
            PG8_WAIT_L(8); PG8_BAR; PG8_WAIT_L(0); PG8_MMA(0, 0, At, B0); PG8_BAR; PG8_SCHED;
            PG8_LDB(B1, 1, 1); PG8_STAGE(PG8_SB(1, 0), b3, voffB);
            PG8_BAR; PG8_WAIT_L(0); PG8_MMA(0, 1, At, B1); PG8_BAR;
            PG8_LDA(At, 1, 1); PG8_STAGE(PG8_SA(1, 0), a3, voffA);
            PG8_BAR; PG8_WAIT_L(0); PG8_MMA(1, 0, At, B0); PG8_BAR; PG8_SCHED;
            PG8_STAGE(PG8_SB(1, 1), b3 + hstep, voffB);
            PG8_WAIT_V(6); PG8_BAR; PG8_MMA(1, 1, At, B1); PG8_BAR;
            }
        }
        if constexpr (ALIGN_EPI) { if (wr == 0) PG8_BAR; }
        if constexpr (!Epi::AFTER_DRAIN) { E(acc, cur, wr, wc, fr, fq, lds + STAGE_BYTES + ((ui & 1) * 8 + wid) * 1024); S.done(cur); }
        if (!has_next) break;
        asm volatile("" : "+v"(zf_));
#pragma unroll
        for (int a = 0; a < 2; ++a)
#pragma unroll
            for (int b = 0; b < 2; ++b)
#pragma unroll
                for (int m = 0; m < 4; ++m)
#pragma unroll
                    for (int n = 0; n < 2; ++n) acc[a][b][m][n] = (f32x4){zf_, zf_, zf_, zf_};
        cur = nxt; cA = nA; cB = nB; ++ui;
        if constexpr (ALIGN_EPI) { if (wr == 1) PG8_BAR; }
    }
    PG8_WAIT_V(0);
    if constexpr (!ALIGN_EPI) { if (wr == 0) PG8_BAR; }
    PG8_BAR;
    if constexpr (Epi::AFTER_DRAIN) { E.fused(acc, cur, wr, wc, fr, fq, lds, wid, lane); S.done(cur); }
#undef PG8_SA
#undef PG8_SB
#undef PG8_STAGE
#undef PG8_LDA
#undef PG8_LDB
#undef PG8_MMA
#undef PG8_WAIT_V
#undef PG8_WAIT_L
#undef PG8_BAR
#undef PG8_SCHED
}
}
#include <hip/hip_bf16.h>
#include <cmath>
namespace attn_body {
using bf16=__hip_bfloat16;
using bf16x8=__attribute__((ext_vector_type(8)))short;
using s16x4=__attribute__((ext_vector_type(4)))short;
using f32x16=__attribute__((ext_vector_type(16)))float;
using u32x4=__attribute__((ext_vector_type(4)))unsigned;
using f32x4v=__attribute__((ext_vector_type(4)))float;
constexpr int BATCH=16,NHEAD=4,SEQ=2048,D=64,DM=NHEAD*D,OPITCH=1024;
constexpr int NW=8,QBLK=32,QB=QBLK*NW,KVBLK=64,NQB=SEQ/QB;
constexpr int ATTN_PITCH=DM, ATTN_UNIT_ROWS=QB;
__device__ __forceinline__ int crow(int r,int hi){return (r&3)+8*(r>>2)+4*hi;}
#define SBAR() __builtin_amdgcn_sched_barrier(0)
__device__ __forceinline__ void cmask(f32x16&p0,f32x16&p1,int jb,int qrel,int hi){
  const float NEG=-INFINITY; int kb=64*jb+4*hi;
  #pragma unroll
  for(int r=0;r<16;++r){int kv=kb+(r&3)+8*(r>>2); if(kv>qrel)p0[r]=NEG; if(kv+32>qrel)p1[r]=NEG;}
}

constexpr int NSLOT=3, SLOTB=8192;
constexpr int LDS_K=0, LDS_V=NSLOT*SLOTB, LDS_WS=2*NSLOT*SLOTB, LDS_OST=LDS_WS+NW*64*4, LDS_BYTES=LDS_OST+NW*4096;
constexpr float C2=0.125f*1.4426950408889634f;
__device__ __forceinline__ void glds16(const void*gsrc,unsigned lds_dst){unsigned keep;
  asm volatile("s_mov_b32 %0, m0\n\ts_mov_b32 m0, %2\n\ts_nop 0\n\tglobal_load_lds_dwordx4 %1, off\n\ts_mov_b32 m0, %0":"=&s"(keep):"v"(gsrc),"s"(lds_dst):"memory");}
__device__ __forceinline__ float max3f(float a,float b,float c){float r;asm("v_max3_f32 %0, %1, %2, %3":"=v"(r):"v"(a),"v"(b),"v"(c));return r;}
__device__ __forceinline__ float max2f(float a,float b){float r;asm("v_max_f32_e32 %0, %1, %2":"=v"(r):"v"(a),"v"(b));return r;}
__device__ __forceinline__ float fadd_s(float a,float b){float r;asm("v_add_f32_e32 %0, %1, %2":"=v"(r):"v"(a),"v"(b));return r;}
__device__ __forceinline__ float fsub_s(float a,float b){float r;asm("v_sub_f32_e32 %0, %1, %2":"=v"(r):"v"(a),"v"(b));return r;}
typedef float f32x2_t __attribute__((ext_vector_type(2))); typedef __bf16 bf16x2_t __attribute__((ext_vector_type(2)));
__device__ __forceinline__ unsigned cvtpk_s(float lo,float hi){f32x2_t v={lo,hi};bf16x2_t b=__builtin_convertvector(v,bf16x2_t);return __builtin_bit_cast(unsigned,b);}
#define WAIT_BAR(N) asm volatile("s_waitcnt vmcnt(" #N ") lgkmcnt(0)\n\ts_barrier":::"memory")

__device__ __forceinline__ void qkt(f32x16&p0,f32x16&p1,const char*Kslot,const bf16x8*qr,int r32,int hi){
  const char*kb=Kslot+hi*1024+r32*16;
  #pragma unroll
  for(int d0=0;d0<4;++d0){
    const bf16x8 b0=*reinterpret_cast<const bf16x8*>(kb+d0*2048);
    const bf16x8 b1=*reinterpret_cast<const bf16x8*>(kb+d0*2048+512);
    p0=__builtin_amdgcn_mfma_f32_32x32x16_bf16(b0,qr[d0],p0,0,0,0);p1=__builtin_amdgcn_mfma_f32_32x32x16_bf16(b1,qr[d0],p1,0,0,0);}
}
typedef __attribute__((address_space(3))) const char* lds_cptr;
typedef short v4i16_t __attribute__((ext_vector_type(4)));
__device__ __forceinline__ void kload8(bf16x8*kf,lds_cptr kp){
  kf[0]=*(const __attribute__((address_space(3))) bf16x8*)(kp);      kf[1]=*(const __attribute__((address_space(3))) bf16x8*)(kp+512);
  kf[2]=*(const __attribute__((address_space(3))) bf16x8*)(kp+2048); kf[3]=*(const __attribute__((address_space(3))) bf16x8*)(kp+2560);
  kf[4]=*(const __attribute__((address_space(3))) bf16x8*)(kp+4096); kf[5]=*(const __attribute__((address_space(3))) bf16x8*)(kp+4608);
  kf[6]=*(const __attribute__((address_space(3))) bf16x8*)(kp+6144); kf[7]=*(const __attribute__((address_space(3))) bf16x8*)(kp+6656);
}
__device__ __forceinline__ void kload2(bf16x8*kf,lds_cptr kp,int j){ kf[2*j]=*(const __attribute__((address_space(3))) bf16x8*)(kp+j*2048); kf[2*j+1]=*(const __attribute__((address_space(3))) bf16x8*)(kp+j*2048+512); }
__device__ __forceinline__ s16x4 vtr(lds_cptr p){ return __builtin_bit_cast(s16x4,__builtin_amdgcn_ds_read_tr16_b64_v4i16((__attribute__((address_space(3))) v4i16_t*)p)); }
__device__ __forceinline__ float rowmax(const f32x16&p0,const f32x16&p1){
  float a=max3f(p0[0],p0[1],p1[0]),b=max3f(p0[2],p0[3],p1[1]);a=max3f(a,p1[2],p1[3]);
  #pragma unroll
  for(int r=4;r<16;r+=4){a=max3f(a,p0[r],p0[r+1]);b=max3f(b,p0[r+2],p0[r+3]);a=max3f(a,p1[r],p1[r+1]);b=max3f(b,p1[r+2],p1[r+3]);}
  const float m=max2f(a,b);
  auto rr=__builtin_amdgcn_permlane32_swap(__float_as_uint(m),__float_as_uint(m),false,false);
  return max2f(__uint_as_float(rr[0]),__uint_as_float(rr[1]));
}
__device__ __forceinline__ void pv(f32x16*o,int vb,bf16x8 pa0,bf16x8 pa1,bf16x8 pa2,bf16x8 pa3){
  #pragma unroll
  for(int d0=0;d0<2;++d0){s16x4 lo[4],hi[4];
    #pragma unroll
    for(int ks=0;ks<4;++ks){
      asm volatile("ds_read_b64_tr_b16 %0,%1 offset:%c2":"=&v"(lo[ks]):"v"(vb),"i"(d0*4096+ks*1024):"memory");
      asm volatile("ds_read_b64_tr_b16 %0,%1 offset:%c2":"=&v"(hi[ks]):"v"(vb),"i"(d0*4096+ks*1024+512):"memory");}
    asm volatile("s_waitcnt lgkmcnt(0)":::"memory");SBAR();
    #define PK(k) (bf16x8){lo[k][0],lo[k][1],lo[k][2],lo[k][3],hi[k][0],hi[k][1],hi[k][2],hi[k][3]}
    o[d0]=__builtin_amdgcn_mfma_f32_32x32x16_bf16(pa0,PK(0),o[d0],0,0,0);
    o[d0]=__builtin_amdgcn_mfma_f32_32x32x16_bf16(pa1,PK(1),o[d0],0,0,0);
    o[d0]=__builtin_amdgcn_mfma_f32_32x32x16_bf16(pa2,PK(2),o[d0],0,0,0);
    o[d0]=__builtin_amdgcn_mfma_f32_32x32x16_bf16(pa3,PK(3),o[d0],0,0,0);
    #undef PK
  }
}

#ifndef ATTN_STORE16
#define ATTN_STORE16(p,v) (*(u32x4*)(p)=(v))
#endif
typedef __attribute__((address_space(3))) const float* lds_cfptr;
template<int THRL> __device__ __forceinline__ void attn_unit(int b,int h,int qb,int tskip,const bf16*Q,const bf16*__restrict__ K,const bf16*__restrict__ V,bf16*O,char*shm,lds_cfptr c2s){
  int tid_=threadIdx.x; asm volatile("":"+v"(tid_));
  const int tid=tid_,lane=tid&63,r32=lane&31,hi=lane>>5; const int wid=__builtin_amdgcn_readfirstlane(tid>>6);
  const long rowbase=(long)b*SEQ; const int q0=qb*QB;
  const bf16*Qw=Q+(rowbase+q0+wid*QBLK)*DM+h*D;
  const bf16*Kh=K+(rowbase+(long)tskip*KVBLK)*DM+h*D,*Vh=V+(rowbase+(long)tskip*KVBLK)*DM+h*D;
  const lds_cfptr c2k=c2s+tskip*KVBLK;
  const unsigned lds0=(unsigned)(uintptr_t)shm;
  float*wsf=(float*)(shm+LDS_WS)+wid*64;
  const bf16*ksrc=Kh+(long)lane*DM+wid*8;
  const bf16*vsrc=Vh+(long)(16*(wid&3)+(lane>>2))*DM+(wid>>2)*32+(lane&3)*8;
  const unsigned kdst=lds0+LDS_K+wid*1024, vdst=lds0+LDS_V+wid*1024;
  #define DMA_K(t,slot) glds16(ksrc+(long)(t)*KVBLK*DM,(unsigned)__builtin_amdgcn_readfirstlane(kdst+(slot)))
  #define DMA_V(t,slot) glds16(vsrc+(long)(t)*KVBLK*DM,(unsigned)__builtin_amdgcn_readfirstlane(vdst+(slot)))
  const int vb0=(int)(lds0+LDS_V)+((lane>>4)&1)*32+(lane&3)*8+(4*hi+((lane&15)>>2))*64;
  const char*Kbase=shm+LDS_K; bf16x8 kf[8];
  const lds_cptr shm3=(lds_cptr)shm; const lds_cptr kp0=shm3+LDS_K+hi*1024+r32*16; const lds_cptr vp0=shm3+LDS_V+((lane>>4)&1)*32+(lane&3)*8+(4*hi+((lane&15)>>2))*64;
  const int NT=(q0+QB)/KVBLK-tskip;
  DMA_K(0,0);DMA_V(0,0);DMA_K(1,SLOTB);
  bf16x8 qr[4];
  #pragma unroll
  for(int d0=0;d0<4;++d0)qr[d0]=*reinterpret_cast<const bf16x8*>(&Qw[(long)r32*DM+d0*16+hi*8]);
  float l_reg=0.f;f32x16 o[2];{float z_=0.f;asm volatile("":"+v"(z_));o[0]=(f32x16){z_,z_,z_,z_,z_,z_,z_,z_,z_,z_,z_,z_,z_,z_,z_,z_};o[1]=o[0];}
  const int qrel=wid*QBLK+r32;
  float qm=c2s[q0+qrel];
  #define BIAS(P0,P1,t) do{ const lds_cfptr cb_=c2k+(t)*KVBLK+4*hi; _Pragma("unroll") for(int g_=0;g_<4;++g_){ const f32x4v a_=*(const __attribute__((address_space(3))) f32x4v*)(cb_+8*g_), b_=*(const __attribute__((address_space(3))) f32x4v*)(cb_+32+8*g_); \
      _Pragma("unroll") for(int i_=0;i_<4;++i_){ P0[4*g_+i_]=qm-a_[i_]; P1[4*g_+i_]=qm-b_[i_]; } } }while(0)
  #define CMASK(P0,P1,t) do{int jb_=(t)-(NT-4); if(jb_>=0)cmask(P0,P1,jb_,qrel,hi);}while(0)
  bool resc=false;
  #define START(P0,P1) do{ const float rm=rowmax(P0,P1); resc=false; \
    { const float dl=rm; qm=fsub_s(qm,dl); \
      _Pragma("unroll") for(int r=0;r<16;++r){P0[r]=fsub_s(P0[r],dl);P1[r]=fsub_s(P1[r],dl);} } \
    _Pragma("unroll") for(int r=0;r<16;++r)P0[r]=__builtin_amdgcn_exp2f(P0[r]); }while(0)
  #define RESC() do{ if(resc){ asm volatile("s_waitcnt lgkmcnt(0)":::"memory"); \
      _Pragma("unroll") for(int d_=0;d_<2;++d_) _Pragma("unroll") for(int r=0;r<16;++r)o[d_][r]*=wsf[crow(r,hi)]; } }while(0)
  f32x16 pA0,pA1,pB0,pB1;
  int sl_prev=0,sl_cur=0,sl_next=SLOTB;
  #define ROT() do{sl_prev=sl_cur;sl_cur=sl_next;sl_next=(sl_next==(NSLOT-1)*SLOTB)?0:sl_next+SLOTB;}while(0)
  DMA_K(2,2*SLOTB);
  WAIT_BAR(3);
  BIAS(pA0,pA1,0); qkt(pA0,pA1,Kbase,qr,r32,hi);asm volatile("s_nop 15\n\ts_nop 7":"+v"(pA0),"+v"(pA1));CMASK(pA0,pA1,0);
  START(pA0,pA1);
  _Pragma("unroll") for(int r=0;r<16;++r)pA1[r]=__builtin_amdgcn_exp2f(pA1[r]);
  WAIT_BAR(0);
  DMA_K(3,0);DMA_V(1,SLOTB);
  ROT();
  kload8(kf,kp0+sl_cur);
  WAIT_BAR(2);
  s16x4 vlo[8],vhi[8]; u32x4 pw0,pw1,pw2,pw3;
  #define PKW(P,B) cvtpk_s(P[B],P[B+1])
  #define PAF(k) __builtin_bit_cast(bf16x8,pw##k)
  #define VFR(i) (bf16x8){vlo[i][0],vlo[i][1],vlo[i][2],vlo[i][3],vhi[i][0],vhi[i][1],vhi[i][2],vhi[i][3]}
  #define PIN(x) asm volatile("":"+v"(x))
  #define MX3(a,b,c) __builtin_fmaxf(__builtin_fmaxf((a),(b)),(c))
  #define GAPA(MF,A0,A1,A2,A3,W0,W1,PW) do{ MF; sacc+=A0; sacc+=A1; sacc+=A2; sacc+=A3; PIN(sacc); W0; W1; PIN(PW); SBAR(); }while(0)
  #define EX(v) __builtin_amdgcn_exp2f(v)
  #define GAPB(MF,X,B) do{ MF; X[B]=EX(X[B]); X[B+1]=EX(X[B+1]); X[B+2]=EX(X[B+2]); X[B+3]=EX(X[B+3]); PIN(X); SBAR(); }while(0)
  #define VRD(i) do{ vlo[i]=vtr(vp_+(((i)>>2)*4096+((i)&3)*1024)); vhi[i]=vtr(vp_+(((i)>>2)*4096+((i)&3)*1024+512)); }while(0)
  #define KRD(G,j) do{ if(G){ kload2(kf,kp0+sl_next,j); SBAR(); } }while(0)
  #define STEP(C0,C1,P0,P1,t,GK,GV,GL) do{ SBAR(); BIAS(C0,C1,t); SBAR(); \
    const lds_cptr vp_=vp0+sl_prev; \
    VRD(0); SBAR(); float sacc=(P0[0]+P0[1]); \
    GAPA(C0=__builtin_amdgcn_mfma_f32_32x32x16_bf16(kf[0],qr[0],C0,0,0,0), P0[2],P0[3],P0[4],P0[5],     pw0[0]=PKW(P0,0), pw0[1]=PKW(P0,2), pw0); \
    VRD(4); SBAR(); GAPA(C1=__builtin_amdgcn_mfma_f32_32x32x16_bf16(kf[1],qr[0],C1,0,0,0), P0[6],P0[7],P0[8],P0[9],     pw0[2]=PKW(P0,4), pw0[3]=PKW(P0,6), pw0); \
    VRD(1); SBAR(); GAPA(C0=__builtin_amdgcn_mfma_f32_32x32x16_bf16(kf[2],qr[1],C0,0,0,0),   P0[10],P0[11],P0[12],P0[13], pw1[0]=PKW(P0,8), pw1[1]=PKW(P0,10), pw1); \
    VRD(5); SBAR(); GAPA(C1=__builtin_amdgcn_mfma_f32_32x32x16_bf16(kf[3],qr[1],C1,0,0,0),   P0[14],P0[15],P1[0],P1[1],   pw1[2]=PKW(P0,12),pw1[3]=PKW(P0,14), pw1); \
    VRD(2); SBAR(); GAPA(C0=__builtin_amdgcn_mfma_f32_32x32x16_bf16(kf[4],qr[2],C0,0,0,0),   P1[2],P1[3],P1[4],P1[5],     pw2[0]=PKW(P1,0), pw2[1]=PKW(P1,2), pw2); \
    VRD(6); SBAR(); GAPA(C1=__builtin_amdgcn_mfma_f32_32x32x16_bf16(kf[5],qr[2],C1,0,0,0),   P1[6],P1[7],P1[8],P1[9],     pw2[2]=PKW(P1,4), pw2[3]=PKW(P1,6), pw2); \
    VRD(3); SBAR(); GAPA(C0=__builtin_amdgcn_mfma_f32_32x32x16_bf16(kf[6],qr[3],C0,0,0,0),   P1[10],P1[11],P1[12],P1[13], pw3[0]=PKW(P1,8), pw3[1]=PKW(P1,10), pw3); \
    VRD(7); SBAR(); GAPA(C1=__builtin_amdgcn_mfma_f32_32x32x16_bf16(kf[7],qr[3],C1,0,0,0),   P1[14],P1[15],0.f,0.f,       pw3[2]=PKW(P1,12),pw3[3]=PKW(P1,14), pw3); \
    l_reg+=sacc; \
    if(GK){DMA_K((t)+3,sl_cur);} if(GV){DMA_V((t)+1,sl_next);} \
    CMASK(C0,C1,t); \
    { float a=MX3(C0[0],C0[1],C1[0]),b=MX3(C0[2],C0[3],C1[1]); a=MX3(a,C1[2],C1[3]); \
      _Pragma("unroll") for(int r=4;r<16;r+=4){a=MX3(a,C0[r],C0[r+1]);b=MX3(b,C0[r+2],C0[r+3]);a=MX3(a,C1[r],C1[r+1]);b=MX3(b,C1[r+2],C1[r+3]);} \
      float rm=__builtin_fmaxf(a,b); { auto rr=__builtin_amdgcn_permlane32_swap(__float_as_uint(rm),__float_as_uint(rm),false,false); rm=__builtin_fmaxf(__uint_as_float(rr[0]),__uint_as_float(rr[1])); } \
      resc=false; \
      if(__builtin_expect(__any(rm>(float)THRL),0)){ const float dl=__builtin_fmaxf(rm,0.f); qm-=dl; \
        _Pragma("unroll") for(int r=0;r<16;++r){C0[r]-=dl;C1[r]-=dl;} \
        const float f=__builtin_amdgcn_exp2f(-dl); l_reg*=f; if(hi==0)wsf[r32]=f; resc=true; } } \
    SBAR(); \
    GAPB(o[0]=__builtin_amdgcn_mfma_f32_32x32x16_bf16(PAF(0),VFR(0),o[0],0,0,0), C0,0); \
    GAPB(o[1]=__builtin_amdgcn_mfma_f32_32x32x16_bf16(PAF(0),VFR(4),o[1],0,0,0), C0,4); \
    KRD(GL,0); GAPB(o[0]=__builtin_amdgcn_mfma_f32_32x32x16_bf16(PAF(1),VFR(1),o[0],0,0,0), C0,8); \
    KRD(GL,1); GAPB(o[1]=__builtin_amdgcn_mfma_f32_32x32x16_bf16(PAF(1),VFR(5),o[1],0,0,0), C0,12); \
    KRD(GL,2); GAPB(o[0]=__builtin_amdgcn_mfma_f32_32x32x16_bf16(PAF(2),VFR(2),o[0],0,0,0), C1,0); \
    KRD(GL,3); GAPB(o[1]=__builtin_amdgcn_mfma_f32_32x32x16_bf16(PAF(2),VFR(6),o[1],0,0,0), C1,4); \
    GAPB(o[0]=__builtin_amdgcn_mfma_f32_32x32x16_bf16(PAF(3),VFR(3),o[0],0,0,0), C1,8); \
    GAPB(o[1]=__builtin_amdgcn_mfma_f32_32x32x16_bf16(PAF(3),VFR(7),o[1],0,0,0), C1,12); \
    }while(0)
  int t=1;
  #undef CMASK
  #define CMASK(P0,P1,t) do{}while(0)
  for(;t+5<NT;t+=2){
    STEP(pB0,pB1,pA0,pA1,t,true,true,true);     WAIT_BAR(2); RESC(); ROT();
    STEP(pA0,pA1,pB0,pB1,t+1,true,true,true);   WAIT_BAR(2); RESC(); ROT();
  }
  #undef CMASK
  #define CMASK(P0,P1,t) do{int jb_=(t)-(NT-4); if(jb_>=0)cmask(P0,P1,jb_,qrel,hi);}while(0)
  #define ENDW(tt) do{ if((tt)+3<NT){WAIT_BAR(2);} else if((tt)+2<NT){WAIT_BAR(1);} else {WAIT_BAR(0);} }while(0)
  for(;t+1<NT;t+=2){
    STEP(pB0,pB1,pA0,pA1,t,(t+3<NT),(t+1<NT),(t+1<NT));       ENDW(t);   RESC(); ROT();
    STEP(pA0,pA1,pB0,pB1,t+1,(t+4<NT),(t+2<NT),(t+2<NT));     ENDW(t+1); RESC(); ROT();
  }
  STEP(pB0,pB1,pA0,pA1,NT-1,false,false,false); RESC();
  { float sacc=pB0[0]+pB0[1]; _Pragma("unroll") for(int r=2;r<16;++r)sacc+=pB0[r]; _Pragma("unroll") for(int r=0;r<16;++r)sacc+=pB1[r]; l_reg+=sacc;
    pw0=(u32x4){PKW(pB0,0),PKW(pB0,2),PKW(pB0,4),PKW(pB0,6)};pw1=(u32x4){PKW(pB0,8),PKW(pB0,10),PKW(pB0,12),PKW(pB0,14)};pw2=(u32x4){PKW(pB1,0),PKW(pB1,2),PKW(pB1,4),PKW(pB1,6)};pw3=(u32x4){PKW(pB1,8),PKW(pB1,10),PKW(pB1,12),PKW(pB1,14)};
    SBAR(); pv(o,vb0+sl_cur,PAF(0),PAF(1),PAF(2),PAF(3)); }
  #undef PKW
  #undef PAF
  #undef VFR
  #undef PIN
  #undef MX3
  #undef GAPA
  #undef GAPB
  #undef EX
  #undef VRD
  #undef KRD
  #undef STEP
  #undef ENDW
  {auto rr=__builtin_amdgcn_permlane32_swap(__float_as_uint(l_reg),__float_as_uint(l_reg),false,false);l_reg=__uint_as_float(rr[0])+__uint_as_float(rr[1]);}
  if(hi==0)wsf[32+r32]=l_reg;asm volatile("s_waitcnt lgkmcnt(0)":::"memory");
  float rli[16];
  #pragma unroll
  for(int r=0;r<16;++r)rli[r]=__builtin_amdgcn_rcpf(wsf[32+crow(r,hi)]);
  bf16*Ow=O+(rowbase+q0+wid*QBLK)*OPITCH+h*D;
  { bf16*stg=(bf16*)(shm+LDS_OST)+wid*2048;
    #pragma unroll
    for(int r=0;r<16;++r){const int orow=crow(r,hi);
      #pragma unroll
      for(int d0=0;d0<2;++d0)stg[orow*64+d0*32+r32]=__float2bfloat16(o[d0][r]*rli[r]);}
    asm volatile("s_waitcnt lgkmcnt(0)":::"memory");
    #pragma unroll
    for(int i=0;i<4;++i){const int row=i*8+(lane>>3),ch=lane&7; const u32x4 v=*(const u32x4*)(stg+row*64+ch*8); ATTN_STORE16(Ow+(long)row*OPITCH+ch*8,v);} }
  asm volatile("s_waitcnt lgkmcnt(0)\n\ts_barrier":::"memory");
  #undef DMA_K
  #undef DMA_V
  #undef CMASK
  #undef START
  #undef RESC
  #undef ROT
  #undef BIAS
}
constexpr int ATTN_LDS_BYTES=LDS_BYTES;
#undef SBAR
#undef WAIT_BAR
}

#define LAS __attribute__((address_space(3)))
#define XB_TMO      128
#define XB_XCNT(j)  (256  + 64 * (j))
#define XB_XSUB(j)  (1280 + 64 * (j))
#define XB_XGEN(j)  (2304 + 64 * (j))
#define XB_TOP      3328
#define XB_TOPGEN   3392
#define XCD_BAR_WORDS 3456
#define XB_SPIN_CAP (1u << 22)

__device__ __forceinline__ unsigned xb_ld(unsigned* p)              { return __hip_atomic_load(p, __ATOMIC_RELAXED, __HIP_MEMORY_SCOPE_AGENT); }
__device__ __forceinline__ unsigned xb_add(unsigned* p, unsigned v) { return __hip_atomic_fetch_add(p, v, __ATOMIC_RELAXED, __HIP_MEMORY_SCOPE_AGENT); }
__device__ __forceinline__ unsigned xb_xcc_id() { return (unsigned)__builtin_amdgcn_s_getreg((3 << 11) | 20) & 0xFu; }
#define XB_SPIN(cond, bar) do { unsigned _sp = 0; while (cond) { __builtin_amdgcn_s_sleep(1); \
    if ((++_sp & 255u) == 0u) { if (xb_ld(&(bar)[XB_TMO])) break; if (_sp > XB_SPIN_CAP) { atomicAdd(&(bar)[XB_TMO], 1u); break; } } } } while (0)

struct XcdBarrier {
    unsigned* bar; unsigned x;
    volatile LAS unsigned* st;
};

__device__ __forceinline__ XcdBarrier xcd_barrier_post(unsigned* bar, volatile LAS unsigned* st) {
    XcdBarrier b; b.bar = bar; b.x = xb_xcc_id(); b.st = st;
    if (threadIdx.x == 0) (void)xb_add(&bar[XB_XCNT(b.x)], 1u);
    return b;
}
__device__ __forceinline__ void xcd_barrier_complete(unsigned* bar, unsigned x, unsigned& nloc, unsigned& nx) {
    const unsigned G = gridDim.x * gridDim.y * gridDim.z;
    unsigned sum, cnt, mine, sp = 0u;
    for (;;) {
        sum = 0u; cnt = 0u; mine = 0u;
#pragma unroll
        for (unsigned j = 0; j < 16; ++j) { const unsigned c = xb_ld(&bar[XB_XCNT(j)]); sum += c; cnt += (c > 0u) ? 1u : 0u; mine = (j == x) ? c : mine; }
        if (sum == G) break;
        __builtin_amdgcn_s_sleep(1);
        if ((++sp & 255u) == 0u) { if (xb_ld(&bar[XB_TMO])) break; if (sp > XB_SPIN_CAP) { atomicAdd(&bar[XB_TMO], 1u); break; } }
    }
    nloc = mine > 0u ? mine : 1u; nx = cnt > 0u ? cnt : 1u;
}

__device__ __forceinline__ void xcd_barrier(const XcdBarrier& b) {
    asm volatile("s_waitcnt vmcnt(0)" ::: "memory");
    __syncthreads();
    if (threadIdx.x == 0) {
        unsigned* bar = b.bar;
        __builtin_amdgcn_s_waitcnt(0);
        unsigned nloc = b.st[0], nx = b.st[1];
        if (nloc == 0u) { xcd_barrier_complete(bar, b.x, nloc, nx); b.st[0] = nloc; b.st[1] = nx; }
        const unsigned old = xb_add(&bar[XB_XSUB(b.x)], 1u);
        const unsigned gen = old / nloc;
        if (old + 1u == (gen + 1u) * nloc) {
            __builtin_amdgcn_fence(__ATOMIC_RELEASE, "agent");
            asm volatile("s_waitcnt vmcnt(0)" ::: "memory");
            const unsigned og = xb_add(&bar[XB_TOP], 1u);
            const unsigned tg = og / nx;
            if (og + 1u == (tg + 1u) * nx) xb_add(&bar[XB_TOPGEN], 1u);
            else XB_SPIN(xb_ld(&bar[XB_TOPGEN]) == tg, bar);
            __builtin_amdgcn_fence(__ATOMIC_ACQUIRE, "agent");
            xb_add(&bar[XB_XGEN(b.x)], 1u);
            asm volatile("s_waitcnt vmcnt(0)" ::: "memory");
        } else {
            XB_SPIN(xb_ld(&bar[XB_XGEN(b.x)]) == gen, bar);
            __builtin_amdgcn_fence(__ATOMIC_ACQUIRE, "agent");
            asm volatile("s_waitcnt vmcnt(0)" ::: "memory");
        }
    }
    __syncthreads();
}

constexpr int NWAVES = 8;
constexpr int NB = 16, SEQ = 2048, DM = 1024, M = NB * SEQ, DFF = 2816, NGU = 2 * DFF, NIN = 13 * 256, INW = 3076, DEPTH = 2;
constexpr size_t MiB = 1u << 20;
constexpr size_t WS_CTL = 0, CTL_ZERO_BYTES = 4 * MiB;
constexpr size_t WS_SSQ7 = 1 * MiB;
constexpr size_t WS_W = 4 * MiB, W_LAYER = 42 * MiB;
constexpr size_t OW_GU1 = 0, OW_D1 = 11 * MiB, OW_IN = OW_D1 + 5 * MiB + 512 * 1024, OW_OUT = OW_IN + 6 * MiB + 512 * 1024, OW_GU2 = OW_OUT + 2 * MiB, OW_D2 = OW_GU2 + 11 * MiB, OW_GLU = OW_D2 + 5 * MiB + 512 * 1024;
static_assert(OW_GLU + 128 * 1024 <= W_LAYER, "weights per layer");
constexpr size_t WS_S5T = 88 * MiB;
constexpr size_t WS_XB = 108 * MiB;
constexpr size_t WS_AF = 172 * MiB;
constexpr size_t WS_LBT = 173 * MiB;
constexpr size_t WS_MIX = 174 * MiB;
constexpr size_t WS_ZB = 238 * MiB;
constexpr size_t WS_R = 256 * MiB;
constexpr size_t WS_END = 480 * MiB;
constexpr int CW_BAR = 4096;
constexpr int RING_OFF = 0, RING_BYTES = 131072;
constexpr int LDS_BYTES = 163840;
constexpr int LDSCTL_OFF = LDS_BYTES - 512, MISC_OFF = LDSCTL_OFF + 320;

#define GAS __attribute__((address_space(1)))
typedef unsigned short bf16;
typedef unsigned v4u __attribute__((ext_vector_type(4)));
typedef float f32x4 __attribute__((ext_vector_type(4)));
#define LDS_WAIT() asm volatile("s_waitcnt lgkmcnt(0)" ::: "memory")
__device__ __forceinline__ unsigned f2bf(float f) { unsigned u = __builtin_bit_cast(unsigned, f); return (u + 0x7fffu + ((u >> 16) & 1u)) >> 16; }
typedef float mk_f32x2 __attribute__((ext_vector_type(2))); typedef __bf16 mk_bf16x2 __attribute__((ext_vector_type(2)));
__device__ __forceinline__ unsigned pk2(float lo, float hi) { const mk_f32x2 v = {lo, hi}; return __builtin_bit_cast(unsigned, __builtin_convertvector(v, mk_bf16x2)); }
__device__ __forceinline__ float bf2f(unsigned short b) { return __uint_as_float((unsigned)b << 16); }
__device__ __forceinline__ float wave_sum(float v) {
#pragma unroll
    for (int o = 1; o < 64; o <<= 1) v += __shfl_xor(v, o);
    return v;
}
__device__ __forceinline__ float wave_max(float v) {
#pragma unroll
    for (int o = 1; o < 64; o <<= 1) v = fmaxf(v, __shfl_xor(v, o));
    return v;
}

#define LDS_BARRIER() do { asm volatile("s_waitcnt lgkmcnt(0)" ::: "memory"); __builtin_amdgcn_s_barrier(); asm volatile("" ::: "memory"); } while (0)
__device__ __forceinline__ float opaque_zero() { float z = 0.f; asm volatile("" : "+v"(z)); return z; }
typedef float mk_f32x16 __attribute__((ext_vector_type(16)));
__device__ __forceinline__ mk_f32x16 zero16() { const float z = opaque_zero(); return (mk_f32x16){z, z, z, z, z, z, z, z, z, z, z, z, z, z, z, z}; }
struct Args { const float* in[27]; float* out; unsigned char* ws; };
typedef const __attribute__((address_space(4))) Args* KArgs;
__device__ __forceinline__ KArgs kargs() { KArgs p = (KArgs)__builtin_amdgcn_kernarg_segment_ptr(); asm volatile("" : "+s"(p)); return p; }

struct Frame {
    LAS unsigned char* lds;
    volatile LAS unsigned* MISC;
    unsigned* ctl;
    int tid, lane, wave, G, bx;
    __device__ __forceinline__ void relaunder() { int t = threadIdx.x; asm volatile("" : "+v"(t)); tid = t; lane = t & 63; wave = __builtin_amdgcn_readfirstlane(t >> 6); int b_ = blockIdx.x, g_ = gridDim.x; asm volatile("" : "+s"(b_), "+s"(g_)); bx = b_; G = g_; }
};

__device__ __forceinline__ void tr_item(const float* W, int K, int ldn, int csrc, int ncv, bf16* WT, int rdst, int kb, const float* gain, LAS float* scr, int lane) {
    const int k0 = 64 * kb, n = lane & 31;
    float wv[32];
#pragma unroll
    for (int i = 0; i < 32; ++i) { const int kk = 2 * i + (lane >> 5); wv[i] = (n < ncv) ? W[(size_t)(k0 + kk) * ldn + csrc + n] : 0.f; }
    if (gain) {
#pragma unroll
        for (int i = 0; i < 32; ++i) wv[i] *= gain[k0 + 2 * i + (lane >> 5)]; }
#pragma unroll
    for (int i = 0; i < 32; ++i) scr[(2 * i + (lane >> 5)) * 33 + n] = wv[i];
    LDS_WAIT(); asm volatile("" ::: "memory");
    const int c = lane & 7;
#pragma unroll
    for (int j = 0; j < 4; ++j) { const int nn = (lane >> 3) + 8 * j; const LAS float* s = scr + (8 * c) * 33 + nn;
        v4u o; o.x = pk2(s[0 * 33], s[1 * 33]); o.y = pk2(s[2 * 33], s[3 * 33]); o.z = pk2(s[4 * 33], s[5 * 33]); o.w = pk2(s[6 * 33], s[7 * 33]);
        *(GAS v4u*)(WT + (size_t)(rdst + nn) * K + k0 + 8 * c) = o; }
    LDS_WAIT(); asm volatile("" ::: "memory");
}

constexpr size_t S5T_STRIDE = 573440, S5T_K = 0, S5T_P = 33280, S5T_Q = 33280 + 262144, S5T_L = 33280 + 2 * 262144;
constexpr int S5_TABLE_ITEMS = 160;
__device__ __forceinline__ void s5_table_item(Frame& F, const KArgs Ap, unsigned char* ws, int item) {
    LAS float* Bbr = (LAS float*)F.lds; LAS float* Bbi = Bbr + 1024; LAS float* Cr = Bbi + 1024; LAS float* Ci = Cr + 1024; LAS float* PWr = Ci + 1024; LAS float* PWi = PWr + 65 * 64;
    const int lg = item < 128 ? item >> 2 : item - 128, l = lg >> 4, g = lg & 15; (void)l; (void)g;
    unsigned char* tbl = ws + WS_S5T + (size_t)lg * S5T_STRIDE;
    LAS float* cfl = PWi + 65 * 64;
    if (F.tid < 64) {
        const int p = F.tid; const float dt = expf(Ap->in[14][lg]);
        const float lr = Ap->in[12][lg * 64 + p], li = Ap->in[13][lg * 64 + p];
        const float mag = expf(lr * dt), lbr = mag * cosf(li * dt), lbi = mag * sinf(li * dt), nr = lbr - 1.0f, ni = lbi, den = lr * lr + li * li;
        cfl[2 * p] = (nr * lr + ni * li) / den; cfl[2 * p + 1] = (ni * lr - nr * li) / den;
        double wr = 1.0, wi = 0.0; const double dlr = (double)lbr, dli = (double)lbi;
#pragma unroll 1
        for (int n = 0; n <= 64; ++n) { PWr[n * 64 + p] = (float)wr; PWi[n * 64 + p] = (float)wi; const double t = wr * dlr - wi * dli; wi = wr * dli + wi * dlr; wr = t; }
    }
    for (int e = F.tid; e < 1024; e += 512) { Cr[e] = Ap->in[17][(size_t)lg * 1024 + e]; Ci[e] = Ap->in[18][(size_t)lg * 1024 + e]; }
    __syncthreads();
    for (int e = F.tid; e < 1024; e += 512) { const int p = e >> 4; const float cfr = cfl[2 * p], cfi = cfl[2 * p + 1];
        const float br = Ap->in[15][(size_t)lg * 1024 + e], bi = Ap->in[16][(size_t)lg * 1024 + e];
        Bbr[e] = cfr * br - cfi * bi; Bbi[e] = cfr * bi + cfi * br; }
    __syncthreads();
    if (item < 128) {
        const int q = item & 3; bf16* KT = (bf16*)(tbl + S5T_K);
        for (int e = F.tid; e < 16 * 256; e += 512) { const int tau = 16 * q + (e >> 8), hp = (e >> 4) & 15, h = e & 15; float acc = 0.f;
#pragma unroll 4
            for (int p = 0; p < 64; ++p) { const float wr = PWr[tau * 64 + p], wi = PWi[tau * 64 + p], br = Bbr[p * 16 + h], bi = Bbi[p * 16 + h];
                const float gr = wr * br - wi * bi, gi = wr * bi + wi * br; acc += Cr[hp * 64 + p] * gr - Ci[hp * 64 + p] * gi; }
            KT[(tau + 1) * 256 + hp * 16 + h] = (bf16)f2bf(acc); }
        if (q == 0 && F.tid < 256) KT[F.tid] = 0;
    } else {
        unsigned* P2 = (unsigned*)(tbl + S5T_P); unsigned* Q2 = (unsigned*)(tbl + S5T_Q); float* L = (float*)(tbl + S5T_L);
        for (int e = F.tid; e < 65536; e += 512) { const int n = e >> 9, k2 = e & 511, p = n >> 1, ri = n & 1, j = k2 >> 3, h = (k2 & 7) * 2;
            const float wr = PWr[(63 - j) * 64 + p], wi = PWi[(63 - j) * 64 + p];
            const float g0 = ri ? wr * Bbi[p * 16 + h] + wi * Bbr[p * 16 + h] : wr * Bbr[p * 16 + h] - wi * Bbi[p * 16 + h];
            const float g1 = ri ? wr * Bbi[p * 16 + h + 1] + wi * Bbr[p * 16 + h + 1] : wr * Bbr[p * 16 + h + 1] - wi * Bbi[p * 16 + h + 1];
            P2[e] = pk2(g0, g1); }
        for (int e = F.tid; e < 65536; e += 512) { const int n = e >> 6, p = e & 63, i = n >> 4, hp = n & 15;
            const float wr = PWr[(i + 1) * 64 + p], wi = PWi[(i + 1) * 64 + p], cr = Cr[hp * 64 + p], ci = Ci[hp * 64 + p];
            Q2[e] = pk2(cr * wr - ci * wi, -(cr * wi + ci * wr)); }
        if (F.tid < 64) { L[2 * F.tid] = PWr[64 * 64 + F.tid]; L[2 * F.tid + 1] = PWi[64 * 64 + F.tid]; }
    }
    __syncthreads();
}
constexpr int IT_G = 88 * 16, IT_D = 32 * 44, IT_IN = 104 * 16, IT_OUT = 32 * 16, IT_GLU = 8 * 4;
constexpr int IT_LAYER = 4 * IT_G + 2 * IT_D + IT_IN + IT_OUT + IT_GLU;
__device__ __forceinline__ void conv_layer(Frame& F, int l, int vb, int nvb) {
    F.relaunder(); const KArgs Ap = kargs(); unsigned char* const A_ws = Ap->ws;
#pragma unroll 1
    for (int it = vb; it < 80; it += nvb) s5_table_item(F, Ap, A_ws, it < 64 ? 64 * l + it : 128 + 16 * l + (it - 64));
    { float* lbt = (float*)(A_ws + WS_LBT) + l * 512;
      for (int e = vb * (NWAVES * 64) + F.tid; e < 512; e += nvb * (NWAVES * 64)) { const float x0 = Ap->in[10][e], x1 = Ap->in[10][512 + e]; const float mx = fmaxf(x0, x1), e0 = expf(x0 - mx), e1 = expf(x1 - mx); lbt[e] = l == 0 ? 0.f : e1 / (e0 + e1); } }
    LAS float* scr = (LAS float*)(F.lds + RING_OFF + F.wave * 16384);
    const int gw = vb * NWAVES + F.wave, NGW = nvb * NWAVES;
#pragma unroll 1
    for (int it = gw; it < IT_LAYER; it += NGW) {
        int r = it;
        unsigned char* wl = A_ws + WS_W + (size_t)l * W_LAYER;
        if (r < 4 * IT_G) {
            const int which = r / IT_G; r %= IT_G; const int blk = r / 16, kb = r % 16; const int ffn = which >> 1, isup = which & 1;
            const float* W = Ap->in[ffn ? (isup ? 25 : 24) : (isup ? 3 : 2)] + (size_t)l * DM * DFF; const float* gain = Ap->in[ffn ? 23 : 1] + l * DM;
            const int col = 32 * blk, rdst = 256 * (col / 128) + (col % 128) + 128 * isup;
            tr_item(W, DM, DFF, col, 32, (bf16*)(wl + (ffn ? OW_GU2 : OW_GU1)), rdst, kb, gain, scr, F.lane); continue; }
        r -= 4 * IT_G;
        if (r < 2 * IT_D) { const int ffn = r / IT_D; r %= IT_D; const int blk = r / 44, kb = r % 44;
            tr_item(Ap->in[ffn ? 26 : 4] + (size_t)l * DFF * DM, DFF, DM, 32 * blk, 32, (bf16*)(wl + (ffn ? OW_D2 : OW_D1)), 32 * blk, kb, nullptr, scr, F.lane); continue; }
        r -= 2 * IT_D;
        if (r < IT_IN) { const int blk = r / 16, kb = r % 16; const int tile = blk >> 3, rb = blk & 7; int csrc, ncv = 32;
            if (tile < 2) { const int bj = rb >> 2, wc = rb & 3; csrc = tile * 256 + 32 * (2 * wc + bj); }
            else if (tile == 2) csrc = 512 + 32 * rb;
            else if (tile < 12) csrc = 772 + (tile - 3) * 256 + 32 * rb;
            else { csrc = 768; ncv = rb == 0 ? 4 : 0; }
            tr_item(Ap->in[6] + (size_t)l * DM * INW, DM, INW, csrc, ncv, (bf16*)(wl + OW_IN), tile * 256 + 32 * rb, kb, Ap->in[5] + l * DM, scr, F.lane); continue; }
        r -= IT_IN;
        if (r < IT_OUT) { const int blk = r / 16, kb = r % 16;
            tr_item(Ap->in[22] + (size_t)l * DM * DM, DM, DM, 32 * blk, 32, (bf16*)(wl + OW_OUT), 32 * blk, kb, nullptr, scr, F.lane); continue; }
        r -= IT_OUT;
        { const int blk = r / 4, kb = r % 4;
            tr_item(Ap->in[20] + (size_t)l * 256 * 256, 256, 256, 32 * blk, 32, (bf16*)(wl + OW_GLU), 32 * blk, kb, nullptr, scr, F.lane); }
    }
}
__device__ __forceinline__ void p0_prologue(Frame& F) {
    F.relaunder(); const KArgs Ap = kargs(); unsigned char* const A_ws = Ap->ws;
    const int gw = F.bx * NWAVES + F.wave, NGW = F.G * NWAVES;
    bf16* XB = (bf16*)(A_ws + WS_XB); pg8::ssq_t* SSQ = (pg8::ssq_t*)(A_ws + WS_SSQ7);
    for (int m = gw; m < M; m += NGW) {
        const GAS f32x4* xr = (const GAS f32x4*)(Ap->in[0] + (size_t)m * DM) + F.lane; f32x4 v[4]; float s = 0.f;
#pragma unroll
        for (int j = 0; j < 4; ++j) { v[j] = xr[64 * j]; s += (v[j].x * v[j].x + v[j].y * v[j].y) + (v[j].z * v[j].z + v[j].w * v[j].w); }
        s = wave_sum(s);
        GAS unsigned long long* o8 = (GAS unsigned long long*)(XB + (size_t)m * DM) + F.lane;
#pragma unroll
        for (int j = 0; j < 4; ++j) o8[64 * j] = (unsigned long long)pk2(v[j].x, v[j].y) | ((unsigned long long)pk2(v[j].z, v[j].w) << 32);
        if (F.lane == 0) SSQ[m] = (pg8::ssq_t)(s * pg8::SSQ_SCALE);
    }
}

__device__ __forceinline__ void naive_attn(Frame& F, int l) {
    F.relaunder(); const KArgs Ap = kargs(); unsigned char* const A_ws = Ap->ws;
    LAS float* c2 = (LAS float*)(F.lds); LAS float* wtot = (LAS float*)(F.lds + 8192);
    const bf16* QB = (const bf16*)(A_ws + WS_R + pg8::EpiWin::O_Q); const bf16* KB = (const bf16*)(A_ws + WS_R + pg8::EpiWin::O_K); const bf16* VB = (const bf16*)(A_ws + WS_R + pg8::EpiWin::O_V);
    const float* AF = (const float*)(A_ws + WS_AF); bf16* MIX = (bf16*)(A_ws + WS_MIX);
    const int lane = F.lane;
    for (int u = F.bx; u < 512; u += F.G) {
        const int bh = u & 63, qq = u >> 6, qb = qq < 4 ? qq : 11 - qq, b = bh >> 2, h = bh & 3;
        { const float fb = Ap->in[7][l * 4 + h]; float ls[4]; float run = 0.f;
#pragma unroll
          for (int j = 0; j < 4; ++j) { const float x = AF[(size_t)(b * SEQ + 4 * F.tid + j) * 4 + h] + fb; run += fminf(x, 0.f) - log1pf(expf(-fabsf(x))); ls[j] = run; }
          float inc = run;
#pragma unroll
          for (int o = 1; o < 64; o <<= 1) { const float t = __shfl_up(inc, o); if (lane >= o) inc += t; }
          if (lane == 63) wtot[F.wave] = inc;
          __syncthreads();
          float base = inc - run; for (int w = 0; w < F.wave; ++w) base += wtot[w];
#pragma unroll
          for (int j = 0; j < 4; ++j) c2[4 * F.tid + j] = (base + ls[j]) * 1.4426950408889634f;
          __syncthreads(); }
#pragma unroll 1
        for (int r = F.wave; r < 256; r += NWAVES) {
            const int t = 256 * qb + r; const size_t rowq = (size_t)(b * SEQ + t);
            const float qv = bf2f(QB[rowq * 256 + h * 64 + lane]); const float ct = c2[t];
            float mrun = -INFINITY, lrun = 0.f, o = 0.f;
#pragma unroll 1
            for (int s0 = 0; s0 <= t; s0 += 64) {
                const int s = s0 + lane; const v4u* kp = (const v4u*)(KB + (size_t)(b * SEQ + s) * 256 + h * 64); float acc = 0.f;
#pragma unroll
                for (int c = 0; c < 8; ++c) { const v4u kv = kp[c]; const unsigned w4[4] = {kv.x, kv.y, kv.z, kv.w};
#pragma unroll
                    for (int e = 0; e < 4; ++e) { const float q0 = __int_as_float(__builtin_amdgcn_readlane(__float_as_int(qv), 8 * c + 2 * e)), q1 = __int_as_float(__builtin_amdgcn_readlane(__float_as_int(qv), 8 * c + 2 * e + 1));
                        acc += q0 * __uint_as_float(w4[e] << 16) + q1 * __uint_as_float(w4[e] & 0xffff0000u); } }
                const float logit = (s <= t) ? acc + ct - c2[s] : -INFINITY;
                const float mn = fmaxf(mrun, wave_max(logit)); const float p = __builtin_amdgcn_exp2f(logit - mn), corr = __builtin_amdgcn_exp2f(mrun - mn);
                lrun = lrun * corr + wave_sum(p); o *= corr; mrun = mn;
                const bf16* vp = VB + (size_t)(b * SEQ + s0) * 256 + h * 64 + lane;
#pragma unroll 8
                for (int ss = 0; ss < 64; ++ss) { const float ps = __int_as_float(__builtin_amdgcn_readlane(__float_as_int(p), ss)); o += ps * bf2f(vp[(size_t)ss * 256]); }
            }
            MIX[rowq * 1024 + h * 64 + lane] = (bf16)f2bf(o / lrun);
        }
        __syncthreads();
    }
}
__device__ __forceinline__ void naive_hgrn(Frame& F, int l) {
    F.relaunder(); const KArgs Ap = kargs(); unsigned char* const A_ws = Ap->ws;
    constexpr int TB = 8;
    LAS float* sf = (LAS float*)(F.lds); LAS float* sk = sf + TB * 128; LAS float* sq = sk + TB * 128; LAS float* si = sq + TB * 128; LAS float* sp = si + TB * 128;
    const bf16* HQ = (const bf16*)(A_ws + WS_R + pg8::EpiWin::O_HQ); const float* HF = (const float*)(A_ws + WS_R + pg8::EpiWin::O_HF);
    const bf16* HI = (const bf16*)(A_ws + WS_R + pg8::EpiWin::O_HI); const bf16* HG = (const bf16*)(A_ws + WS_R + pg8::EpiWin::O_HG); bf16* MIX = (bf16*)(A_ws + WS_MIX);
    const int v = F.tid & 127, kq = F.tid >> 7;
    for (int u = F.bx; u < 64; u += F.G) {
        const int b = u >> 2, h = u & 3;
        float S[32];
#pragma unroll
        for (int i = 0; i < 32; ++i) S[i] = 0.f;
        float lbv = 0.f; { const int k = h * 128 + (F.tid & 127); if (l == 1) { const float a0 = Ap->in[10][k], a1 = Ap->in[10][512 + k]; const float mx = fmaxf(a0, a1); const float e0 = expf(a0 - mx), e1 = expf(a1 - mx); lbv = e1 / (e0 + e1); } }
        const float og = Ap->in[11][l * 512 + h * 128 + (F.lane)], og2 = Ap->in[11][l * 512 + h * 128 + 64 + F.lane];
#pragma unroll 1
        for (int t0 = 0; t0 < SEQ; t0 += TB) {
#pragma unroll
            for (int e = 0; e < 2; ++e) { const int idx = F.tid + 512 * e, tok = idx >> 7, k = idx & 127; const size_t row = (size_t)(b * SEQ + t0 + tok);
                const float x = HF[row * 512 + h * 128 + k]; const float sg = 1.0f / (1.0f + expf(-x)); const float f = lbv + (1.0f - lbv) * sg;
                sf[idx] = f; sk[idx] = 1.0f - f; sq[idx] = bf2f(HQ[row * 512 + h * 128 + k]); si[idx] = bf2f(HI[row * 512 + h * 128 + k]); }
            __syncthreads();
#pragma unroll 1
            for (int tok = 0; tok < TB; ++tok) { const float iv = si[tok * 128 + v]; float part = 0.f;
#pragma unroll
                for (int i = 0; i < 32; i += 4) { const f32x4 f4 = *(const LAS f32x4*)(sf + tok * 128 + kq * 32 + i), k4 = *(const LAS f32x4*)(sk + tok * 128 + kq * 32 + i), q4 = *(const LAS f32x4*)(sq + tok * 128 + kq * 32 + i);
#pragma unroll
                    for (int e = 0; e < 4; ++e) { S[i + e] = f4[e] * S[i + e] + k4[e] * iv; part += S[i + e] * q4[e]; } }
                sp[(tok * 4 + kq) * 128 + v] = part; }
            __syncthreads();
            { const int tok = F.wave; const size_t row = (size_t)(b * SEQ + t0 + tok);
              const float o0 = (sp[(tok * 4 + 0) * 128 + F.lane] + sp[(tok * 4 + 1) * 128 + F.lane]) + (sp[(tok * 4 + 2) * 128 + F.lane] + sp[(tok * 4 + 3) * 128 + F.lane]);
              const float o1 = (sp[(tok * 4 + 0) * 128 + 64 + F.lane] + sp[(tok * 4 + 1) * 128 + 64 + F.lane]) + (sp[(tok * 4 + 2) * 128 + 64 + F.lane] + sp[(tok * 4 + 3) * 128 + 64 + F.lane]);
              const float rs = 1.0f / sqrtf(wave_sum(o0 * o0 + o1 * o1) * (1.0f / 128.0f) + 1e-6f);
              const float g0 = bf2f(HG[row * 512 + h * 128 + F.lane]), g1 = bf2f(HG[row * 512 + h * 128 + 64 + F.lane]);
              MIX[row * 1024 + 256 + h * 128 + F.lane] = (bf16)f2bf(o0 * rs * og * (g0 / (1.0f + expf(-g0))));
              MIX[row * 1024 + 256 + h * 128 + 64 + F.lane] = (bf16)f2bf(o1 * rs * og2 * (g1 / (1.0f + expf(-g1)))); }
            __syncthreads();
        }
    }
}
__device__ __forceinline__ void naive_s5(Frame& F, int l) {
    F.relaunder(); const KArgs Ap = kargs(); unsigned char* const A_ws = Ap->ws;
    const bf16* SU = (const bf16*)(A_ws + WS_R + pg8::EpiWin::O_SU); bf16* ZB = (bf16*)(A_ws + WS_ZB);
    const int p = F.lane;
#pragma unroll 1
    for (int u = F.bx; u < 256; u += F.G) {
        const int b = u >> 4, g = u & 15;
        const double lr = (double)Ap->in[12][(l * 16 + g) * 64 + p], li = (double)Ap->in[13][(l * 16 + g) * 64 + p], dt = exp((double)Ap->in[14][l * 16 + g]);
        const double mag = exp(lr * dt), lbr = mag * cos(li * dt), lbi = mag * sin(li * dt), nr = lbr - 1.0, ni = lbi, den = lr * lr + li * li;
        const double cfr = (nr * lr + ni * li) / den, cfi = (ni * lr - nr * li) / den;
        float Br[16], Bi[16];
#pragma unroll
        for (int hh = 0; hh < 16; ++hh) { const double br = (double)Ap->in[15][((size_t)(l * 16 + g) * 64 + p) * 16 + hh], bi = (double)Ap->in[16][((size_t)(l * 16 + g) * 64 + p) * 16 + hh];
            Br[hh] = (float)(cfr * br - cfi * bi); Bi[hh] = (float)(cfr * bi + cfi * br); }
        const int h0 = 2 * F.wave;
        const float c0r = Ap->in[17][((size_t)(l * 16 + g) * 16 + h0) * 64 + p], c0i = Ap->in[18][((size_t)(l * 16 + g) * 16 + h0) * 64 + p];
        const float c1r = Ap->in[17][((size_t)(l * 16 + g) * 16 + h0 + 1) * 64 + p], c1i = Ap->in[18][((size_t)(l * 16 + g) * 16 + h0 + 1) * 64 + p];
        const float d0 = Ap->in[19][l * 256 + g * 16 + h0], d1 = Ap->in[19][l * 256 + g * 16 + h0 + 1];
        const float ar = (float)lbr, ai = (float)lbi; float xr = 0.f, xi = 0.f;
#pragma unroll 1
        for (int t = 0; t < SEQ; ++t) {
            const size_t row = (size_t)(b * SEQ + t); const v4u* up = (const v4u*)(SU + ((size_t)g * M + row) * 16); const v4u ua = up[0], ub = up[1];
            const unsigned w8[8] = {ua.x, ua.y, ua.z, ua.w, ub.x, ub.y, ub.z, ub.w}; float uu[16];
#pragma unroll
            for (int e = 0; e < 8; ++e) { uu[2 * e] = __uint_as_float(w8[e] << 16); uu[2 * e + 1] = __uint_as_float(w8[e] & 0xffff0000u); }
            float bur = 0.f, bui = 0.f;
#pragma unroll
            for (int hh = 0; hh < 16; ++hh) { bur += Br[hh] * uu[hh]; bui += Bi[hh] * uu[hh]; }
            const float nxr = ar * xr - ai * xi + bur, nxi = ar * xi + ai * xr + bui; xr = nxr; xi = nxi;
            float y0 = wave_sum(c0r * xr - c0i * xi), y1 = wave_sum(c1r * xr - c1i * xi);
            float u0 = 0.f, u1 = 0.f;
#pragma unroll
            for (int hh = 0; hh < 16; ++hh) { if (hh == h0) u0 = uu[hh]; if (hh == h0 + 1) u1 = uu[hh]; }
            y0 += d0 * u0; y1 += d1 * u1;
            const float z0 = 0.5f * y0 * (1.0f + tanhf(0.7978845608028654f * (y0 + 0.044715f * y0 * y0 * y0))), z1 = 0.5f * y1 * (1.0f + tanhf(0.7978845608028654f * (y1 + 0.044715f * y1 * y1 * y1)));
            if (p == 0) *(unsigned*)(ZB + row * 256 + g * 16 + h0) = pk2(z0, z1);
        }
    }
}


constexpr int ATT_C2_OFF = 86016;
static_assert(attn_body::ATTN_LDS_BYTES <= ATT_C2_OFF && ATT_C2_OFF + 8192 + 64 <= RING_BYTES, "attention LDS map");
__device__ __forceinline__ void fast_attn(Frame& F, char* ldsg, int l) {
    F.relaunder(); const KArgs Ap = kargs(); unsigned char* const A_ws = Ap->ws;
    LAS float* c2 = (LAS float*)(F.lds + ATT_C2_OFF); LAS float* wtot = (LAS float*)(F.lds + ATT_C2_OFF + 8192);
    const attn_body::bf16* QB = (const attn_body::bf16*)(A_ws + WS_R + pg8::EpiWin::O_Q); const attn_body::bf16* KB = (const attn_body::bf16*)(A_ws + WS_R + pg8::EpiWin::O_K); const attn_body::bf16* VB = (const attn_body::bf16*)(A_ws + WS_R + pg8::EpiWin::O_V);
    const float* AF = (const float*)(A_ws + WS_AF); attn_body::bf16* MIX = (attn_body::bf16*)(A_ws + WS_MIX);
    const int lane = F.lane;
    const float mq = wave_max(fabsf(Ap->in[8][l * 64 + lane])), mk = wave_max(fabsf(Ap->in[9][l * 64 + lane]));
    const float prune_th = 150.0f + 8.0f + 1.0f + 2.0f * 1.02f * (0.125f * 1.4426950408889634f * 64.0f) * mq * mk;
#pragma unroll 1
    for (int v = (F.G == 256 ? F.bx - 64 : F.bx); v >= 0 && v < 192; v += (F.G == 256 ? 192 : F.G)) {
        const int bh = v < 64 ? v : (v - 64) >> 1, sh = v < 64 ? 0 : 1 + ((v - 64) & 1), b = bh >> 2, h = bh & 3;
        { const float fb = Ap->in[7][l * 4 + h]; float ls[4]; float run = 0.f;
#pragma unroll
          for (int j = 0; j < 4; ++j) { const float x = AF[(size_t)(b * SEQ + 4 * F.tid + j) * 4 + h] + fb; run += fminf(x, 0.f) - log1pf(expf(-fabsf(x))); ls[j] = run; }
          float inc = run;
#pragma unroll
          for (int o = 1; o < 64; o <<= 1) { const float t = __shfl_up(inc, o); if (lane >= o) inc += t; }
          if (lane == 63) wtot[F.wave] = inc;
          __syncthreads();
          float base = inc - run; for (int w = 0; w < F.wave; ++w) base += wtot[w];
#pragma unroll
          for (int j = 0; j < 4; ++j) c2[4 * F.tid + j] = (base + ls[j]) * 1.4426950408889634f;
          __syncthreads(); }
        const int nun = sh == 0 ? 1 : sh == 1 ? 3 : 4;
#pragma unroll 1
        for (int i = 0; i < nun; ++i) { const int qb = sh == 0 ? 7 : sh == 1 ? (i == 0 ? 6 : i == 1 ? 5 : 0) : 4 - i;
            int tskip = 4 * qb; const float cq0 = c2[256 * qb];
#pragma unroll 1
            for (; tskip > 0; tskip -= 2) if (c2[64 * tskip - 1] - cq0 > prune_th) break;
            tskip = __builtin_amdgcn_readfirstlane(tskip);
            attn_body::attn_unit<8>(b, h, qb, tskip, QB, KB, VB, MIX, ldsg + RING_OFF, (attn_body::lds_cfptr)c2); }
    }
}

constexpr int S5_KT_OFF = 0, S5_EP_OFF = 50176, S5_XC_OFF = 83968, S5_XC_STRIDE = 272, S5_U_OFF = 92672, S5_U_CH = 2064, S5_END = S5_U_OFF + 32 * S5_U_CH;
static_assert(S5_XC_OFF + 32 * S5_XC_STRIDE <= S5_U_OFF && S5_END <= LDSCTL_OFF, "S5 LDS map");
__device__ __forceinline__ int crow16(int r, int hi) { return (r & 3) + 8 * (r >> 2) + 4 * hi; }
template <int A0> __device__ __forceinline__ void s5_seg(mk_f32x16 (&acc)[4], int j0, int j1, const LAS unsigned char* ul, const LAS unsigned char* kt, const int (&kb)[4]) {
    typedef short bf16x8 __attribute__((ext_vector_type(8)));
#pragma unroll 2
    for (int j = j0; j < j1; ++j) { const bf16x8 af = *(const LAS bf16x8*)(ul + j * 32);
#pragma unroll
        for (int a = A0; a < 4; ++a) { const bf16x8 bfr = *(const LAS bf16x8*)(kt + kb[a] - j * 768); acc[a] = __builtin_amdgcn_mfma_f32_32x32x16_bf16(af, bfr, acc[a], 0, 0, 0); } }
}
__device__ __forceinline__ void fast_s5(Frame& F, int l) {
    F.relaunder(); const KArgs Ap = kargs(); unsigned char* const A_ws = Ap->ws;
    typedef short bf16x8 __attribute__((ext_vector_type(8))); typedef float f32x16 __attribute__((ext_vector_type(16)));
    const bf16* SU = (const bf16*)(A_ws + WS_R + pg8::EpiWin::O_SU); bf16* ZB = (bf16*)(A_ws + WS_ZB);
    const int lane = F.lane, r32 = lane & 31, hi = lane >> 5, w = F.wave;
    LAS unsigned char* kt = F.lds + S5_KT_OFF; LAS float* Ep = (LAS float*)(F.lds + S5_EP_OFF); LAS unsigned char* xc = F.lds + S5_XC_OFF; LAS unsigned char* ui = F.lds + S5_U_OFF;
#pragma unroll 1
    for (int u = (F.G == 256 ? F.bx - 64 : F.bx); u >= 0 && u < 256; u += (F.G == 256 ? 192 : F.G)) {
        const int b = u >> 4, g = u & 15; const unsigned char* tbl = A_ws + WS_S5T + (size_t)(l * 16 + g) * S5T_STRIDE;
        const bf16* Ug = SU + ((size_t)g * M + (size_t)b * SEQ) * 16;
#pragma unroll
        for (int e = 0; e < 8; ++e) { const int pc = F.tid + 512 * e, tok = pc >> 1; const v4u val = *(const v4u*)((const unsigned char*)Ug + (size_t)pc * 16); *(LAS v4u*)(ui + (tok >> 6) * S5_U_CH + (tok & 63) * 32 + (pc & 1) * 16) = val; }
        for (int pc = F.tid; pc < 2080; pc += 512) { const v4u val = *(const v4u*)(tbl + S5T_K + (size_t)pc * 16); *(LAS v4u*)(kt + (pc >> 1) * 48 + (pc & 1) * 16) = val; }
        LDS_BARRIER();
        const LAS unsigned char* ul = ui + r32 * S5_U_CH + 16 * hi;
        {
            const int nt = w & 3, kh = w >> 2;
            const unsigned po = (unsigned)((32 * nt + r32) * 1024 + (32 * kh) * 16 + 8 * hi); const bf16* Pt = (const bf16*)(tbl + S5T_P);
            f32x16 acc = zero16();
#pragma unroll 16
            for (int ks = 0; ks < 32; ++ks) { const bf16x8 a = *(const LAS bf16x8*)(ul + (32 * kh + ks) * 32), bq = *(const bf16x8*)(Pt + (po + ks * 16)); acc = __builtin_amdgcn_mfma_f32_32x32x16_bf16(a, bq, acc, 0, 0, 0); }
#pragma unroll
            for (int r = 0; r < 16; ++r) Ep[(kh * 32 + crow16(r, hi)) * 128 + 32 * nt + r32] = acc[r];
        }
        LDS_BARRIER();
        if (w == 0) {
            const float* L = (const float*)(tbl + S5T_L); const float ar = L[2 * lane], ai = L[2 * lane + 1]; float xr = 0.f, xi = 0.f;
#pragma unroll 4
            for (int c = 0; c < 32; ++c) { *(LAS unsigned*)(xc + c * S5_XC_STRIDE + 4 * lane) = pk2(xr, xi);
                const float er = Ep[c * 128 + 2 * lane] + Ep[(32 + c) * 128 + 2 * lane], ei = Ep[c * 128 + 2 * lane + 1] + Ep[(32 + c) * 128 + 2 * lane + 1];
                const float nxr = ar * xr - ai * xi + er, nxi = ar * xi + ai * xr + ei; xr = nxr; xi = nxi; }
        }
        LDS_BARRIER();
        {
            const int nts[4] = {w, 15 - w, 16 + w, 31 - w}; const int il = r32 >> 4, hp = r32 & 15;
            f32x16 acc[4] = {zero16(), zero16(), zero16(), zero16()};
            int kb[4];
#pragma unroll
            for (int a = 0; a < 4; ++a) kb[a] = ((2 * nts[a] + il + 1) * 16 + hp) * 48 + hi * 16;
            s5_seg<0>(acc, 0, 2 * w + 2, ul, kt, kb); s5_seg<1>(acc, 2 * w + 2, 32 - 2 * w, ul, kt, kb); s5_seg<2>(acc, 32 - 2 * w, 34 + 2 * w, ul, kt, kb); s5_seg<3>(acc, 34 + 2 * w, 64 - 2 * w, ul, kt, kb);
            const bf16* Qt = (const bf16*)(tbl + S5T_Q);
#pragma unroll
            for (int a = 0; a < 4; ++a) { const bf16* qa = Qt + (size_t)((32 * nts[a] + r32) * 128 + 8 * hi); const LAS unsigned char* xa_ = xc + r32 * S5_XC_STRIDE + 16 * hi;
#pragma unroll
                for (int ks = 0; ks < 8; ++ks) { const bf16x8 af = *(const LAS bf16x8*)(xa_ + 32 * ks), bfr = *(const bf16x8*)(qa + 16 * ks); acc[a] = __builtin_amdgcn_mfma_f32_32x32x16_bf16(af, bfr, acc[a], 0, 0, 0); }
                asm volatile("" ::: "memory"); }
            const float dv = Ap->in[19][l * 256 + g * 16 + hp]; bf16* const Zb = ZB + (size_t)b * SEQ * 256;
            int il_ = il, hp_ = hp, hi_ = hi; asm volatile("" : "+v"(il_), "+v"(hp_), "+v"(hi_));
#pragma unroll
            for (int a = 0; a < 4; ++a)
#pragma unroll
                for (int r = 0; r < 16; ++r) { const int c = crow16(r, hi_), i = 2 * nts[a] + il_, t = 64 * c + i;
                    const float y = acc[a][r] + dv * bf2f(*(const LAS unsigned short*)(ui + c * S5_U_CH + i * 32 + hp_ * 2));
                    const float aa = 0.7978845608028654f * (y + 0.044715f * y * y * y); const float z = y * __builtin_amdgcn_rcpf(1.0f + __builtin_amdgcn_exp2f(-2.0f * 1.4426950408889634f * aa));
                    Zb[(unsigned)(t * 256 + g * 16 + hp_)] = (bf16)f2bf(z); }
        }
        LDS_BARRIER();
    }
}

constexpr int HG_RS = 144, HG_QE = 0, HG_QX = 18432, HG_KE = 36864, HG_KX1 = 55296, HG_KX0 = 73728, HG_KX0_RS = 80, HG_I = 83968, HG_X = 100352, HG_ST = 109568, HG_ST_RS = 272,
              HG_OB = 144384, HG_OB_RS = 272, HG_DEC = 161792, HG_END = 162304;
static_assert(HG_END <= LDSCTL_OFF && HG_OB + 64 * HG_OB_RS <= HG_DEC && HG_ST + 128 * HG_ST_RS <= HG_OB, "HGRN LDS map");
typedef short hg_s16x4 __attribute__((ext_vector_type(4)));
__device__ __forceinline__ hg_s16x4 hg_tr(LAS unsigned char* p) { return __builtin_bit_cast(hg_s16x4, __builtin_amdgcn_ds_read_tr16_b64_v4i16((LAS hg_s16x4*)p)); }
__device__ __forceinline__ void hg_epilogue(LAS unsigned char* L, int tid, v4u gt0, v4u gt1, bf16* mp) {
    const int tk = tid >> 3, part = tid & 7; const LAS v4u* op = (const LAS v4u*)(L + HG_OB + tk * HG_OB_RS + part * 32);
    const v4u oa = op[0], ob = op[1]; const unsigned ow[8] = {oa.x, oa.y, oa.z, oa.w, ob.x, ob.y, ob.z, ob.w}; const unsigned gw[8] = {gt0.x, gt0.y, gt0.z, gt0.w, gt1.x, gt1.y, gt1.z, gt1.w};
    float ov[16]; float ss = 0.f;
#pragma unroll
    for (int e = 0; e < 8; ++e) { ov[2 * e] = __uint_as_float(ow[e] << 16); ov[2 * e + 1] = __uint_as_float(ow[e] & 0xffff0000u); ss += ov[2 * e] * ov[2 * e] + ov[2 * e + 1] * ov[2 * e + 1]; }
    ss += __shfl_xor(ss, 1); ss += __shfl_xor(ss, 2); ss += __shfl_xor(ss, 4);
    const float rs = __builtin_amdgcn_rsqf(ss * (1.0f / 128.0f) + 1e-6f); unsigned res[8];
#pragma unroll
    for (int e = 0; e < 8; ++e) { const float ga = __uint_as_float(gw[e] << 16), gb = __uint_as_float(gw[e] & 0xffff0000u);
        res[e] = pk2(ov[2 * e] * rs * ga, ov[2 * e + 1] * rs * gb); }
    *(v4u*)mp = (v4u){res[0], res[1], res[2], res[3]}; *(v4u*)(mp + 8) = (v4u){res[4], res[5], res[6], res[7]};
}
__device__ __forceinline__ void fast_hgrn(Frame& F, int l) {
    F.relaunder(); const KArgs Ap = kargs(); unsigned char* const A_ws = Ap->ws;
    typedef short bf16x8 __attribute__((ext_vector_type(8))); typedef float f32x16 __attribute__((ext_vector_type(16)));
    const bf16* HQ = (const bf16*)(A_ws + WS_R + pg8::EpiWin::O_HQ); const float* HF = (const float*)(A_ws + WS_R + pg8::EpiWin::O_HF);
    const bf16* HI = (const bf16*)(A_ws + WS_R + pg8::EpiWin::O_HI); const bf16* HG = (const bf16*)(A_ws + WS_R + pg8::EpiWin::O_HG); bf16* MIX = (bf16*)(A_ws + WS_MIX);
    const int tid = F.tid, lane = F.lane, w = F.wave, r32 = lane & 31, hi = lane >> 5, i16 = lane & 15, g1 = (lane >> 4) & 1;
    const int k = 16 * w + (lane & 15), I4 = lane >> 4;
    LAS unsigned char* const L = F.lds; LAS float* const dec = (LAS float*)(L + HG_DEC);
    const int a0 = (8 * hi + (i16 >> 2)) * HG_RS + (16 * g1 + 4 * (i16 & 3)) * 2;
    const int a0k0 = (8 * hi + (i16 >> 2)) * HG_KX0_RS + (16 * g1 + 4 * (i16 & 3)) * 2;
    const int i0 = (8 * hi + (i16 >> 2)) * 64 + (16 * g1 + 4 * (i16 & 3)) * 2;
#pragma unroll 1
    for (int u = F.bx; u < 64; u += F.G) {
        const int b = u >> 2, h = u & 3; const size_t row0 = (size_t)b * SEQ;
        const unsigned char* const HFb = (const unsigned char*)(HF + row0 * 512 + h * 128); const unsigned char* const HQb = (const unsigned char*)(HQ + row0 * 512 + h * 128); const unsigned fo4 = (unsigned)(k + 16 * I4 * 512) * 4, qo2 = (unsigned)(k + 16 * I4 * 512) * 2;
#define HG_LDF(trow) (*(const float*)(HFb + (size_t)(trow) * 2048 + fo4))
#define HG_LDQ(trow) ((unsigned)*(const unsigned short*)(HQb + (size_t)(trow) * 1024 + qo2))
        const unsigned char* const HIb = (const unsigned char*)(HI + row0 * 512 + h * 128); const unsigned hio = (unsigned)((16 * ((tid >> 6) & 3) + ((tid >> 2) & 15)) * 512 + 32 * (tid >> 8) + 8 * (tid & 3)) * 2;
#define HG_LDI(trow, half) (*(const v4u*)(HIb + (size_t)(trow) * 1024 + hio + 128 * (half)))
        const unsigned go2 = (unsigned)((tid >> 3) * 512 + 16 * (tid & 7)) * 2, mo2 = (unsigned)((tid >> 3) * 1024 + 16 * (tid & 7)) * 2;
        static_assert(HG_X + 64 * HG_RS == HG_ST, "X image directly below the state image");
        for (int e = tid; e < (64 * HG_RS + 128 * HG_ST_RS) / 16; e += 512) { const unsigned zu = __float_as_uint(opaque_zero()); *(LAS v4u*)(L + HG_X + e * 16) = (v4u){zu, zu, zu, zu}; }
        f32x16 S0 = zero16(), S1 = zero16();
        float xf[16]; unsigned qraw[16]; v4u inext0, inext1; unsigned qe[8], qx[8], ke[8], k1[8], k0[8]; float btot_p; v4u gt0 = {0u, 0u, 0u, 0u}, gt1 = {0u, 0u, 0u, 0u};
#pragma unroll
        for (int tt = 0; tt < 16; ++tt) { xf[tt] = HG_LDF(tt); qraw[tt] = HG_LDQ(tt); }
        inext0 = HG_LDI(0, 0); inext1 = HG_LDI(0, 1);
        {
              { float run = xf[0];
#pragma unroll
              for (int tt = 1; tt < 16; ++tt) run *= xf[tt];
              const float P0 = __shfl(run, lane & 15), P1 = __shfl(run, 16 + (lane & 15)), P2 = __shfl(run, 32 + (lane & 15)), P3 = __shfl(run, 48 + (lane & 15));
              const bool up = I4 >= 2;
              const float c1 = P0 * P1, T23 = P2 * P3, ptot = c1 * T23;
              const float pf = (I4 & 1) ? (up ? P2 : P0) : 1.0f;
              const float ck = up ? T23 : ptot, cq = up ? c1 : 1.0f, ckx = up ? 1.0f : c1;
              typedef float f32x2 __attribute__((ext_vector_type(2)));
              float E = pf;
#pragma unroll
              for (int p2 = 0; p2 < 8; ++p2) { const float E0 = E * xf[2 * p2], E1 = E0 * xf[2 * p2 + 1]; E = E1;
                  const f32x2 q2 = {__uint_as_float(qraw[2 * p2] << 16), __uint_as_float(qraw[2 * p2 + 1] << 16)}; const f32x2 vqx = q2 * (f32x2){E0, E1}, vqe = vqx * cq;
                  qe[p2] = pk2(vqe[0], vqe[1]); qx[p2] = pk2(vqx[0], vqx[1]); }
              float Gb = fminf(__builtin_amdgcn_rcpf(E), 1.2676506e30f);
#pragma unroll
              for (int p2 = 7; p2 >= 0; --p2) { const float G1 = Gb, G0 = G1 * xf[2 * p2 + 1]; Gb = G0 * xf[2 * p2];
                  const f32x2 kk2 = (f32x2){1.0f, 1.0f} - (f32x2){xf[2 * p2], xf[2 * p2 + 1]};
                  const f32x2 vk0 = kk2 * (f32x2){G0, G1}, vk1 = vk0 * ckx, vke = vk0 * ck;
                  ke[p2] = pk2(vke[0], vke[1]); k1[p2] = pk2(vk1[0], vk1[1]); k0[p2] = pk2(vk0[0], vk0[1]); }
              btot_p = ptot; }
            { LAS unsigned char* wp = L + k * HG_RS + 32 * I4;
              *(LAS v4u*)(wp + HG_QE) = (v4u){qe[0], qe[1], qe[2], qe[3]}; *(LAS v4u*)(wp + HG_QE + 16) = (v4u){qe[4], qe[5], qe[6], qe[7]};
              *(LAS v4u*)(wp + HG_QX) = (v4u){qx[0], qx[1], qx[2], qx[3]}; *(LAS v4u*)(wp + HG_QX + 16) = (v4u){qx[4], qx[5], qx[6], qx[7]};
              *(LAS v4u*)(wp + HG_KE) = (v4u){ke[0], ke[1], ke[2], ke[3]}; *(LAS v4u*)(wp + HG_KE + 16) = (v4u){ke[4], ke[5], ke[6], ke[7]};
              *(LAS v4u*)(wp + HG_KX1) = (v4u){k1[0], k1[1], k1[2], k1[3]}; *(LAS v4u*)(wp + HG_KX1 + 16) = (v4u){k1[4], k1[5], k1[6], k1[7]};
              if (I4 < 2) { LAS unsigned char* wq = L + HG_KX0 + k * HG_KX0_RS + 32 * I4; *(LAS v4u*)wq = (v4u){k0[0], k0[1], k0[2], k0[3]}; *(LAS v4u*)(wq + 16) = (v4u){k0[4], k0[5], k0[6], k0[7]}; }
              if (I4 == 0) dec[k] = btot_p;
              *(LAS v4u*)(L + HG_I + tid * 16) = inext0; *(LAS v4u*)(L + HG_I + (tid + 512) * 16) = inext1; }
        }
#pragma unroll
        for (int tt = 0; tt < 16; ++tt) { xf[tt] = HG_LDF(64 + tt); qraw[tt] = HG_LDQ(64 + tt); }
        inext0 = HG_LDI(64, 0); inext1 = HG_LDI(64, 1);
#pragma unroll 1
        for (int c = 0; c < 32; ++c) {
            const size_t t0 = (size_t)64 * c;
            LDS_BARRIER();
            if (c > 0) hg_epilogue(L, tid, gt0, gt1, (bf16*)((unsigned char*)(MIX + (row0 + t0 - 64) * 1024 + 256 + h * 128) + mo2));
            { const unsigned char* gp = (const unsigned char*)(HG + (row0 + t0) * 512 + h * 128) + go2; gt0 = *(const v4u*)gp; gt1 = *(const v4u*)(gp + 16); }
#pragma unroll 1
            for (int st = w; st < 10; st += 8) {
                const int sb = st < 4 ? 0 : st < 7 ? 1 : st < 9 ? 2 : 3, tb = st < 4 ? st : st < 7 ? st - 3 : st < 9 ? st - 5 : 3;
                const int G4 = lane >> 4;
                LAS unsigned char* ap = (tb < 2) ? (L + HG_KX0 + (8 * G4 + (i16 >> 2)) * HG_KX0_RS + (16 * sb + 4 * (i16 & 3)) * 2) : (L + HG_KX1 + (8 * G4 + (i16 >> 2)) * HG_RS + (16 * sb + 4 * (i16 & 3)) * 2);
                const int ars = (tb < 2) ? HG_KX0_RS : HG_RS;
                LAS unsigned char* bp = L + HG_QX + (8 * G4 + (i16 >> 2)) * HG_RS + (16 * tb + 4 * (i16 & 3)) * 2;
                f32x4 xa = {0.f, 0.f, 0.f, 0.f};
#pragma unroll
                for (int ks = 0; ks < 4; ++ks) { const hg_s16x4 al = hg_tr(ap + ks * 32 * ars), ah = hg_tr(ap + ks * 32 * ars + 4 * ars), bl_ = hg_tr(bp + ks * 32 * HG_RS), bh_ = hg_tr(bp + ks * 32 * HG_RS + 4 * HG_RS);
                    const bf16x8 af = __builtin_shufflevector(al, ah, 0, 1, 2, 3, 4, 5, 6, 7), bfr = __builtin_shufflevector(bl_, bh_, 0, 1, 2, 3, 4, 5, 6, 7);
                    xa = __builtin_amdgcn_mfma_f32_16x16x32_bf16(af, bfr, xa, 0, 0, 0); }
                if (sb == tb) {
#pragma unroll
                    for (int r = 0; r < 4; ++r) if (4 * G4 + r > i16) xa[r] = 0.f; }
                typedef unsigned u32x2_t __attribute__((ext_vector_type(2)));
                *(LAS u32x2_t*)(L + HG_X + (16 * tb + i16) * HG_RS + (16 * sb + 4 * G4) * 2) = (u32x2_t){pk2(xa[0], xa[1]), pk2(xa[2], xa[3])};
            }
            f32x16 oacc = zero16();
            bf16x8 ifr[4];
            { const int vb = w & 3, hf = w >> 2;
#pragma unroll
              for (int ss = 0; ss < 4; ++ss) { const hg_s16x4 lo = hg_tr(L + HG_I + (vb * 4 + ss) * 1024 + i0), hh = hg_tr(L + HG_I + (vb * 4 + ss) * 1024 + i0 + 256); ifr[ss] = __builtin_shufflevector(lo, hh, 0, 1, 2, 3, 4, 5, 6, 7); }
              LAS unsigned char* qp = L + HG_QE + a0 + 64 * hf; LAS unsigned char* sp = L + HG_ST + (32 * vb + r32) * HG_ST_RS + 16 * hi;
#pragma unroll
              for (int ks = 0; ks < 8; ++ks) { const hg_s16x4 al = hg_tr(qp + ks * 16 * HG_RS), ah = hg_tr(qp + ks * 16 * HG_RS + 4 * HG_RS);
                  const bf16x8 af = __builtin_shufflevector(al, ah, 0, 1, 2, 3, 4, 5, 6, 7), bfr = *(const LAS bf16x8*)(sp + 32 * ks);
                  oacc = __builtin_amdgcn_mfma_f32_32x32x16_bf16(af, bfr, oacc, 0, 0, 0); }
              LAS unsigned char* kp = L + HG_KE + (64 * hf + r32) * HG_RS + 16 * hi;
#pragma unroll
              for (int g = 0; g < 4; ++g) { const f32x4 d0 = *(const LAS f32x4*)(dec + 64 * hf + 8 * g + 4 * hi), d1 = *(const LAS f32x4*)(dec + 64 * hf + 32 + 8 * g + 4 * hi);
#pragma unroll
                  for (int e = 0; e < 4; ++e) { S0[4 * g + e] *= d0[e]; S1[4 * g + e] *= d1[e]; } }
#pragma unroll
              for (int ss = 0; ss < 4; ++ss) { const bf16x8 af0 = *(const LAS bf16x8*)(kp + 32 * ss), af1 = *(const LAS bf16x8*)(kp + 32 * HG_RS + 32 * ss);
                  S0 = __builtin_amdgcn_mfma_f32_32x32x16_bf16(af0, ifr[ss], S0, 0, 0, 0); S1 = __builtin_amdgcn_mfma_f32_32x32x16_bf16(af1, ifr[ss], S1, 0, 0, 0); }
            }
            {
              { float run = xf[0];
#pragma unroll
              for (int tt = 1; tt < 16; ++tt) run *= xf[tt];
              const float P0 = __shfl(run, lane & 15), P1 = __shfl(run, 16 + (lane & 15)), P2 = __shfl(run, 32 + (lane & 15)), P3 = __shfl(run, 48 + (lane & 15));
              const bool up = I4 >= 2;
              const float c1 = P0 * P1, T23 = P2 * P3, ptot = c1 * T23;
              const float pf = (I4 & 1) ? (up ? P2 : P0) : 1.0f;
              const float ck = up ? T23 : ptot, cq = up ? c1 : 1.0f, ckx = up ? 1.0f : c1;
              typedef float f32x2 __attribute__((ext_vector_type(2)));
              float E = pf;
#pragma unroll
              for (int p2 = 0; p2 < 8; ++p2) { const float E0 = E * xf[2 * p2], E1 = E0 * xf[2 * p2 + 1]; E = E1;
                  const f32x2 q2 = {__uint_as_float(qraw[2 * p2] << 16), __uint_as_float(qraw[2 * p2 + 1] << 16)}; const f32x2 vqx = q2 * (f32x2){E0, E1}, vqe = vqx * cq;
                  qe[p2] = pk2(vqe[0], vqe[1]); qx[p2] = pk2(vqx[0], vqx[1]); }
              float Gb = fminf(__builtin_amdgcn_rcpf(E), 1.2676506e30f);
#pragma unroll
              for (int p2 = 7; p2 >= 0; --p2) { const float G1 = Gb, G0 = G1 * xf[2 * p2 + 1]; Gb = G0 * xf[2 * p2];
                  const f32x2 kk2 = (f32x2){1.0f, 1.0f} - (f32x2){xf[2 * p2], xf[2 * p2 + 1]};
                  const f32x2 vk0 = kk2 * (f32x2){G0, G1}, vk1 = vk0 * ckx, vke = vk0 * ck;
                  ke[p2] = pk2(vke[0], vke[1]); k1[p2] = pk2(vk1[0], vk1[1]); k0[p2] = pk2(vk0[0], vk0[1]); }
              btot_p = ptot; }
            }
#pragma unroll
            for (int p2 = 0; p2 < 8; ++p2) asm volatile("" : "+v"(qe[p2]), "+v"(qx[p2]), "+v"(ke[p2]), "+v"(k1[p2]), "+v"(k0[p2]));
            asm volatile("" : "+v"(btot_p));
            LDS_BARRIER();
            { const int hf = w >> 2; LAS unsigned char* xq = L + HG_X + (32 * hf + r32) * HG_RS + 16 * hi;
#pragma unroll
              for (int ss = 0; ss < 4; ++ss) if (ss < 2 * hf + 2) { const bf16x8 af = *(const LAS bf16x8*)(xq + 32 * ss); oacc = __builtin_amdgcn_mfma_f32_32x32x16_bf16(af, ifr[ss], oacc, 0, 0, 0); } }
            { const int vb = w & 3, hf = w >> 2;
              LAS unsigned char* ob = L + HG_OB + (32 * vb + r32) * 2;
#pragma unroll
              for (int r = 0; r < 16; ++r) *(LAS unsigned short*)(ob + (32 * hf + crow16(r, hi)) * HG_OB_RS) = (unsigned short)f2bf(oacc[r]);
              LAS unsigned char* sw = L + HG_ST + (32 * vb + r32) * HG_ST_RS + (64 * hf + 4 * hi) * 2;
#pragma unroll
              for (int g = 0; g < 4; ++g) { typedef unsigned u32x2_t __attribute__((ext_vector_type(2)));
                  *(LAS u32x2_t*)(sw + 16 * g) = (u32x2_t){pk2(S0[4 * g], S0[4 * g + 1]), pk2(S0[4 * g + 2], S0[4 * g + 3])};
                  *(LAS u32x2_t*)(sw + 64 + 16 * g) = (u32x2_t){pk2(S1[4 * g], S1[4 * g + 1]), pk2(S1[4 * g + 2], S1[4 * g + 3])}; } }
            {
            { LAS unsigned char* wp = L + k * HG_RS + 32 * I4;
              *(LAS v4u*)(wp + HG_QE) = (v4u){qe[0], qe[1], qe[2], qe[3]}; *(LAS v4u*)(wp + HG_QE + 16) = (v4u){qe[4], qe[5], qe[6], qe[7]};
              *(LAS v4u*)(wp + HG_QX) = (v4u){qx[0], qx[1], qx[2], qx[3]}; *(LAS v4u*)(wp + HG_QX + 16) = (v4u){qx[4], qx[5], qx[6], qx[7]};
              *(LAS v4u*)(wp + HG_KE) = (v4u){ke[0], ke[1], ke[2], ke[3]}; *(LAS v4u*)(wp + HG_KE + 16) = (v4u){ke[4], ke[5], ke[6], ke[7]};
              *(LAS v4u*)(wp + HG_KX1) = (v4u){k1[0], k1[1], k1[2], k1[3]}; *(LAS v4u*)(wp + HG_KX1 + 16) = (v4u){k1[4], k1[5], k1[6], k1[7]};
              if (I4 < 2) { LAS unsigned char* wq = L + HG_KX0 + k * HG_KX0_RS + 32 * I4; *(LAS v4u*)wq = (v4u){k0[0], k0[1], k0[2], k0[3]}; *(LAS v4u*)(wq + 16) = (v4u){k0[4], k0[5], k0[6], k0[7]}; }
              if (I4 == 0) dec[k] = btot_p;
              *(LAS v4u*)(L + HG_I + tid * 16) = inext0; *(LAS v4u*)(L + HG_I + (tid + 512) * 16) = inext1; }
              const size_t tn = (size_t)64 * (c + 2 < 32 ? c + 2 : 31); inext0 = HG_LDI(tn, 0); inext1 = HG_LDI(tn, 1);
#pragma unroll
              for (int tt = 0; tt < 16; ++tt) { xf[tt] = HG_LDF(tn + tt); qraw[tt] = HG_LDQ(tn + tt); } }
        }
        LDS_BARRIER();
        hg_epilogue(L, tid, gt0, gt1, (bf16*)((unsigned char*)(MIX + (row0 + (size_t)31 * 64) * 1024 + 256 + h * 128) + mo2));
        __syncthreads();
    }
}
#undef HG_LDF
#undef HG_LDQ
#undef HG_LDI

__global__ void __launch_bounds__(NWAVES * 64, 2) mega_fwd(Args args) {
    extern __shared__ __attribute__((aligned(16))) unsigned char lds[];
    Frame F;
    F.lds = (LAS unsigned char*)lds; F.MISC = (volatile LAS unsigned*)(F.lds + MISC_OFF);
    F.tid = threadIdx.x; F.lane = F.tid & 63; F.wave = __builtin_amdgcn_readfirstlane(F.tid >> 6); F.G = gridDim.x;
    F.ctl = (unsigned*)(kargs()->ws + WS_CTL);
    for (int u = F.tid; u < (LDS_BYTES - LDSCTL_OFF) / 4; u += NWAVES * 64) ((LAS unsigned*)(F.lds + LDSCTL_OFF))[u] = 0u;
    __syncthreads();
    XcdBarrier bar = xcd_barrier_post(F.ctl + CW_BAR, F.MISC + 8);
#define GRID_BAR() do { XcdBarrier b_ = bar; asm volatile("" : "+s"(b_.bar), "+s"(b_.x)); xcd_barrier(b_); } while (0)

#ifndef REP_PRO
#define REP_PRO 1
#endif
#ifndef REP_GU
#define REP_GU 1
#endif
#ifndef REP_WIN
#define REP_WIN 1
#endif
#ifndef REP_MIX
#define REP_MIX 1
#endif
#ifndef REP_HGRN
#define REP_HGRN 1
#endif
#ifndef REP_ATTN
#define REP_ATTN 1
#endif
#ifndef REP_S5
#define REP_S5 1
#endif
#pragma unroll 1
    for (int j = -1; j < 2 * DEPTH; ++j) {
        const int l = j < 0 ? 0 : j >> 1, ffn = j < 0 ? 0 : j & 1;
        if (j >= 0) {
#pragma unroll 1
        for (int rep = 0; rep < REP_GU; ++rep)
        {
            const KArgs ka = kargs(); unsigned char* const ws = ka->ws; unsigned char* const wl = ws + WS_W + (size_t)l * W_LAYER; bf16* const XB = (bf16*)(ws + WS_XB); pg8::ssq_t* const SSQ7 = (pg8::ssq_t*)(ws + WS_SSQ7); bf16* const ACT = (bf16*)(ws + WS_R); bf16* const MIX = (bf16*)(ws + WS_MIX); bf16* const ZB = (bf16*)(ws + WS_ZB); float* const AF = (float*)(ws + WS_AF); (void)wl; (void)XB; (void)SSQ7; (void)ACT; (void)MIX; (void)ZB; (void)AF;
            pg8::Gemm g{XB, (const bf16*)(wl + (ffn ? OW_GU2 : OW_GU1)), M, NGU, DM}; pg8::StaticOrder S; F.relaunder(); S.init(M, NGU, F.G, F.bx);
            pg8::EpiSwiglu E{ACT, SSQ7 + (size_t)(ffn ? 2 + 3 * l : 3 * l) * M};
            pg8::gemm_phase<pg8::EpiSwiglu, pg8::StaticOrder, true, true>(F.lds + RING_OFF, g, S, E);
            GRID_BAR(); }
#ifndef REP_DN
#define REP_DN 1
#endif
#pragma unroll 1
        for (int rep = 0; rep < REP_DN; ++rep)
        {
            const KArgs ka = kargs(); unsigned char* const ws = ka->ws; unsigned char* const wl = ws + WS_W + (size_t)l * W_LAYER; bf16* const XB = (bf16*)(ws + WS_XB); pg8::ssq_t* const SSQ7 = (pg8::ssq_t*)(ws + WS_SSQ7); bf16* const ACT = (bf16*)(ws + WS_R); bf16* const MIX = (bf16*)(ws + WS_MIX); bf16* const ZB = (bf16*)(ws + WS_ZB); float* const AF = (float*)(ws + WS_AF); (void)wl; (void)XB; (void)SSQ7; (void)ACT; (void)MIX; (void)ZB; (void)AF;
            pg8::Gemm g{ACT, (const bf16*)(wl + (ffn ? OW_D2 : OW_D1)), M, DM, DFF}; pg8::StaticOrder S; F.relaunder(); S.init(M, DM, F.G, F.bx);
            pg8::EpiResid E{XB, (j == 2 * DEPTH - 1 && rep == REP_DN - 1) ? ka->out : (float*)nullptr, SSQ7 + (size_t)(rep == REP_DN - 1 ? (ffn ? (3 + 3 * l) % 7 : 1 + 3 * l) : 7) * M, 0.5f / REP_DN};
            pg8::gemm_phase<pg8::EpiResid, pg8::StaticOrder, true, true>(F.lds + RING_OFF, g, S, E);
            GRID_BAR(); }
        }
        if (ffn == 0) {
            if (j >= 0) {
#pragma unroll 1
            for (int rep = 0; rep < REP_WIN; ++rep)
            {
            const KArgs ka = kargs(); unsigned char* const ws = ka->ws; unsigned char* const wl = ws + WS_W + (size_t)l * W_LAYER; bf16* const XB = (bf16*)(ws + WS_XB); pg8::ssq_t* const SSQ7 = (pg8::ssq_t*)(ws + WS_SSQ7); bf16* const ACT = (bf16*)(ws + WS_R); bf16* const MIX = (bf16*)(ws + WS_MIX); bf16* const ZB = (bf16*)(ws + WS_ZB); float* const AF = (float*)(ws + WS_AF); (void)wl; (void)XB; (void)SSQ7; (void)ACT; (void)MIX; (void)ZB; (void)AF;
                pg8::Gemm g{XB, (const bf16*)(wl + OW_IN), M, NIN, DM}; pg8::StaticOrder S; F.relaunder(); S.init(M, NIN, F.G, F.bx);
                pg8::EpiWin E{ws + WS_R, SSQ7 + (size_t)(1 + 3 * l) * M, ka->in[8] + l * 64, ka->in[9] + l * 64, AF, (const float*)(ws + WS_LBT) + l * 512, ka->in[11] + l * 512};
                pg8::gemm_phase<pg8::EpiWin, pg8::StaticOrder, true, true>(F.lds + RING_OFF, g, S, E);
                GRID_BAR(); }
#pragma unroll 1
            for (int rm = 0; rm < REP_MIX; ++rm) {
            if (rm > 0) GRID_BAR();
#ifdef NAIVE_HGRN
            naive_hgrn(F, l);
#else
            for (int r2 = 0; r2 < REP_HGRN; ++r2) fast_hgrn(F, l);
#endif
#ifdef NAIVE_ATTN
            naive_attn(F, l);
#else
            for (int r2 = 0; r2 < REP_ATTN; ++r2) fast_attn(F, (char*)lds, l);
#endif
#ifdef NAIVE_S5
            naive_s5(F, l);
#else
            for (int r2 = 0; r2 < REP_S5; ++r2) fast_s5(F, l);
#endif
            }
            }
            if (j <= 0) { F.relaunder(); const bool sub = j == 0 && F.G == 256; if (!sub || F.bx >= 64) conv_layer(F, j + 1, sub ? F.bx - 64 : F.bx, sub ? 192 : F.G); }
            if (j < 0) p0_prologue(F);
            GRID_BAR();
            if (j >= 0) {
            {
            const KArgs ka = kargs(); unsigned char* const ws = ka->ws; unsigned char* const wl = ws + WS_W + (size_t)l * W_LAYER; bf16* const XB = (bf16*)(ws + WS_XB); pg8::ssq_t* const SSQ7 = (pg8::ssq_t*)(ws + WS_SSQ7); bf16* const ACT = (bf16*)(ws + WS_R); bf16* const MIX = (bf16*)(ws + WS_MIX); bf16* const ZB = (bf16*)(ws + WS_ZB); float* const AF = (float*)(ws + WS_AF); (void)wl; (void)XB; (void)SSQ7; (void)ACT; (void)MIX; (void)ZB; (void)AF;
                pg8::Gemm g{ZB, (const bf16*)(wl + OW_GLU), M, 256, 256}; pg8::StaticOrder S; F.relaunder(); S.init(M, 256, F.G, F.bx);
                pg8::EpiGlu E{ZB, ka->in[21] + l * 256, MIX};
                pg8::gemm_phase<pg8::EpiGlu, pg8::StaticOrder, true, true>(F.lds + RING_OFF, g, S, E);
                GRID_BAR(); }
            {
            const KArgs ka = kargs(); unsigned char* const ws = ka->ws; unsigned char* const wl = ws + WS_W + (size_t)l * W_LAYER; bf16* const XB = (bf16*)(ws + WS_XB); pg8::ssq_t* const SSQ7 = (pg8::ssq_t*)(ws + WS_SSQ7); bf16* const ACT = (bf16*)(ws + WS_R); bf16* const MIX = (bf16*)(ws + WS_MIX); bf16* const ZB = (bf16*)(ws + WS_ZB); float* const AF = (float*)(ws + WS_AF); (void)wl; (void)XB; (void)SSQ7; (void)ACT; (void)MIX; (void)ZB; (void)AF;
                pg8::Gemm g{MIX, (const bf16*)(wl + OW_OUT), M, DM, DM}; pg8::StaticOrder S; F.relaunder(); S.init(M, DM, F.G, F.bx);
                pg8::EpiResid E{XB, (float*)nullptr, SSQ7 + (size_t)(2 + 3 * l) * M, 1.0f};
                pg8::gemm_phase<pg8::EpiResid, pg8::StaticOrder, true, true>(F.lds + RING_OFF, g, S, E);
                GRID_BAR(); }
            }
        }
    }
}

extern "C" void kernel_launch(void* const* d_in, const int* in_sizes, int n_in, void* d_out, int out_size, void* d_ws, size_t ws_size, hipStream_t stream) {
    static int grid = 0;
    if (grid == 0) {
        if (n_in != 27 || in_sizes[0] != M * DM || out_size != M * DM || ws_size < WS_END) { fprintf(stderr, "kernel_launch: unexpected shapes: n_in %d in0 %d out %d ws %zu (need %zu)\n", n_in, n_in > 0 ? in_sizes[0] : -1, out_size, ws_size, (size_t)WS_END); grid = -1; return; }
        int dev = 0, cus = 0, per_cu = 0;
        if (hipGetDevice(&dev) != hipSuccess || hipDeviceGetAttribute(&cus, hipDeviceAttributeMultiprocessorCount, dev) != hipSuccess) { grid = -1; return; }
        if (hipFuncSetAttribute((const void*)mega_fwd, hipFuncAttributeMaxDynamicSharedMemorySize, LDS_BYTES) != hipSuccess) { fprintf(stderr, "kernel_launch: hipFuncSetAttribute failed\n"); grid = -1; return; }
        if (hipOccupancyMaxActiveBlocksPerMultiprocessor(&per_cu, (const void*)mega_fwd, NWAVES * 64, LDS_BYTES) != hipSuccess || per_cu < 1) fprintf(stderr, "kernel_launch: occupancy query says %d\n", per_cu);
        (void)hipGetLastError();
        grid = cus;
    }
    if (grid < 0) return;
    if (hipMemsetAsync((char*)d_ws + WS_CTL, 0, CTL_ZERO_BYTES, stream) != hipSuccess) return;
    Args a{};
    for (int i = 0; i < 27; ++i) a.in[i] = (const float*)d_in[i];
    a.out = (float*)d_out; a.ws = (unsigned char*)d_ws;
    hipLaunchKernelGGL(mega_fwd, dim3(grid), dim3(NWAVES * 64), LDS_BYTES, stream, a);
}
```

```cpp
#include <hip/hip_runtime.h>
#include <cstdio>
#include <cstdint>
#include <cmath>
namespace pg8 {
#define PG8_LAS __attribute__((address_space(3)))
typedef unsigned short bf16_t;
typedef short bf16x8 __attribute__((ext_vector_type(8)));
typedef float f32x4 __attribute__((ext_vector_type(4)));
typedef unsigned u32x4 __attribute__((ext_vector_type(4)));
constexpr int BM = 256, BK = 64, HALF = 128, HTB = HALF * BK * 2  , STAGE_BYTES = 8 * HTB, NXCD = 8, WGM = 8;

__host__ __device__ __forceinline__ int lds_byte(int r, int c) { const int st = (r >> 4) * 2 + (c >> 5), rr = r & 15, cc = c & 31, ob = rr * 64 + cc * 2; return st * 1024 + (ob ^ (((ob >> 9) & 1) << 5)); }
__host__ __device__ __forceinline__ void stage_rc(int b, int& R, int& C) { const int st = b / 1024, sb = b % 1024, swz = sb ^ (((sb >> 9) & 1) << 5); R = (st >> 1) * 16 + swz / 64; C = (st & 1) * 32 + (swz % 64) / 2; }
__host__ __device__ __forceinline__ int perm32(int rho) { const int n = rho >> 4, i = rho & 15; return 8 * (i >> 2) + 4 * n + (i & 3); }

struct Unit { int pm, pn; };
struct Gemm { const bf16_t* A; const bf16_t* Bt; int M, N, K; };

struct StaticOrder {
    int nM, nN, nwg, G, c;
    __host__ __device__ void init(int M, int N, int G_, int c_) { nM = M / BM; nN = N / BM; nwg = nM * nN; G = G_; c = c_; }
    __host__ __device__ bool next(int i, Unit& u) const {
        const long L = (long)i * G + c; if (L >= nwg) return false;
        int wgid = (int)L; { const int q = nwg / NXCD, r = nwg % NXCD, xcd = wgid % NXCD, off = wgid / NXCD; wgid = (xcd < r ? xcd * (q + 1) : r * (q + 1) + (xcd - r) * q) + off; }
        const int nig = WGM * nN, gid = wgid / nig, fm = gid * WGM, gsz = (nM - fm) < WGM ? (nM - fm) : WGM;
        u.pm = fm + ((wgid % nig) % gsz); u.pn = (wgid % nig) / gsz; return true;
    }
    __device__ __forceinline__ void a_ready(const Unit&) const {}
    __device__ __forceinline__ void done(const Unit&) const {}
};


typedef float f32x2 __attribute__((ext_vector_type(2))); typedef __bf16 bf16x2_cv __attribute__((ext_vector_type(2)));
__device__ __forceinline__ unsigned cvt_pk_bf16(float lo, float hi) { const f32x2 v = {lo, hi}; return __builtin_bit_cast(unsigned, __builtin_convertvector(v, bf16x2_cv)); }
typedef unsigned u32x2 __attribute__((ext_vector_type(2)));
constexpr float RMS_EPS = 1e-6f;
typedef unsigned long long ssq_t;
constexpr float SSQ_SCALE = 16777216.0f, SSQ_INV = 1.0f / (16777216.0f * 1024.0f);
__device__ __forceinline__ float rstd_of(ssq_t s) { return __builtin_amdgcn_rsqf((float)s * SSQ_INV + RMS_EPS); }
__device__ __forceinline__ void prefetch_ssq(const ssq_t* ssq, const Unit& u, int par, PG8_LAS unsigned char* hi, int wid, int lane) {
    const ssq_t* src = ssq + (size_t)u.pm * BM + 128 * (lane >> 5) + 64 * (wid >> 2) + 2 * (lane & 31);
    __builtin_amdgcn_global_load_lds((const unsigned*)src, (PG8_LAS unsigned*)(hi + (par * 8 + wid) * 1024), 16, 0, 0);
}
#define PG8_RSTD8(r8, slot, fr) float r8[2][4]; { _Pragma("unroll") for (int ai_ = 0; ai_ < 2; ++ai_) _Pragma("unroll") for (int m_ = 0; m_ < 4; ++m_) r8[ai_][m_] = rstd_of(*(const PG8_LAS ssq_t*)((slot) + (64 * ai_ + 16 * m_ + (fr)) * 8)); }
__device__ __forceinline__ float silu_f(float g) { return g * __builtin_amdgcn_rcpf(1.0f + __builtin_amdgcn_exp2f(-1.4426950408889634f * g)); }
__device__ __forceinline__ float sigmoid_f(float g) { return __builtin_amdgcn_rcpf(1.0f + __builtin_amdgcn_exp2f(-1.4426950408889634f * g)); }

struct EpiSwiglu {
    static constexpr bool PERM = true, AFTER_DRAIN = false;
    bf16_t* O; const ssq_t* ssq;
    static constexpr int VM_OPS = 8;
    __device__ __forceinline__ void prefetch(const Unit& u, int par, PG8_LAS unsigned char* hi, int wid, int lane) const { prefetch_ssq(ssq, u, par, hi, wid, lane); }
    __device__ __forceinline__ void operator()(const f32x4 (&acc)[2][2][4][2], const Unit& u, int wr, int wc, int fr_, int fq_, const PG8_LAS unsigned char* slot) const {
        int fr = fr_, fq = fq_; asm volatile("" : "+v"(fr), "+v"(fq));
        const int row0 = u.pm * BM + wr * 64 + fr, col0 = u.pn * 128 + wc * 32 + 8 * fq;
        PG8_RSTD8(r8, slot, fr);
#pragma unroll
        for (int ai = 0; ai < 2; ++ai)
#pragma unroll
            for (int m = 0; m < 4; ++m) { const int row = row0 + ai * HALF + m * 16; const float r = r8[ai][m];
                u32x4 w; unsigned ww[4];
                const float rl = -1.4426950408889634f * r, rr = r * r;
#pragma unroll
                for (int n = 0; n < 2; ++n) { const f32x4 G = acc[ai][0][m][n], gu = G * acc[ai][1][m][n] * rr; float o4[4];
#pragma unroll
                    for (int i = 0; i < 4; ++i) o4[i] = gu[i] * __builtin_amdgcn_rcpf(1.0f + __builtin_amdgcn_exp2f(G[i] * rl));
                    ww[2 * n] = cvt_pk_bf16(o4[0], o4[1]); ww[2 * n + 1] = cvt_pk_bf16(o4[2], o4[3]); }
                w.x = ww[0]; w.y = ww[1]; w.z = ww[2]; w.w = ww[3];
                *(u32x4*)(O + (size_t)row * 2816 + col0) = w; }
    }
};

struct EpiResid {
    static constexpr bool PERM = true, AFTER_DRAIN = false;
    bf16_t* xb; float* outf; ssq_t* ssq; float alpha;
    static constexpr int VM_OPS = 24;
    __device__ __forceinline__ void prefetch(const Unit&, int, PG8_LAS unsigned char*, int, int) const {}
    __device__ __forceinline__ void operator()(const f32x4 (&acc)[2][2][4][2], const Unit& u, int wr, int wc, int fr_, int fq_, const PG8_LAS unsigned char* slot) const {
        int fr = fr_, fq = fq_; asm volatile("" : "+v"(fr), "+v"(fq));
        const int row0 = u.pm * BM + wr * 64 + fr, col0 = u.pn * BM + wc * 32 + 8 * fq;
#pragma unroll
        for (int ai = 0; ai < 2; ++ai) {
            u32x4 rv[4][2];
#pragma unroll
            for (int m = 0; m < 4; ++m)
#pragma unroll
                for (int bj = 0; bj < 2; ++bj) rv[m][bj] = *(const u32x4*)(xb + (size_t)(row0 + ai * HALF + m * 16) * 1024 + col0 + bj * HALF);
#pragma unroll
            for (int m = 0; m < 4; ++m) { const int row = row0 + ai * HALF + m * 16; const size_t off = (size_t)row * 1024 + col0; float ss = 0.f;
#pragma unroll
                for (int bj = 0; bj < 2; ++bj) { const u32x4 r4 = rv[m][bj];
                    const f32x4 o0 = (f32x4){__uint_as_float(r4.x << 16), __uint_as_float(r4.x & 0xffff0000u), __uint_as_float(r4.y << 16), __uint_as_float(r4.y & 0xffff0000u)} + acc[ai][bj][m][0] * alpha;
                    const f32x4 o1 = (f32x4){__uint_as_float(r4.z << 16), __uint_as_float(r4.z & 0xffff0000u), __uint_as_float(r4.w << 16), __uint_as_float(r4.w & 0xffff0000u)} + acc[ai][bj][m][1] * alpha;
                    ss += ((o0[0] * o0[0] + o0[1] * o0[1]) + (o0[2] * o0[2] + o0[3] * o0[3])) + ((o1[0] * o1[0] + o1[1] * o1[1]) + (o1[2] * o1[2] + o1[3] * o1[3]));
                    if (outf) { *(f32x4*)(outf + off + bj * HALF) = o0; *(f32x4*)(outf + off + bj * HALF + 4) = o1; }
                    else { u32x4 w; w.x = cvt_pk_bf16(o0[0], o0[1]); w.y = cvt_pk_bf16(o0[2], o0[3]); w.z = cvt_pk_bf16(o1[0], o1[1]); w.w = cvt_pk_bf16(o1[2], o1[3]); *(u32x4*)(xb + off + bj * HALF) = w; } }
                ss += __shfl_xor(ss, 16); ss += __shfl_xor(ss, 32);
                if (fq == 0 && !outf) __hip_atomic_fetch_add(ssq + row, (ssq_t)(ss * SSQ_SCALE), __ATOMIC_RELAXED, __HIP_MEMORY_SCOPE_AGENT); }
            asm volatile("" ::: "memory"); }
    }
};

struct EpiWin {
    static constexpr bool PERM = true, AFTER_DRAIN = false;
    unsigned char* R; const ssq_t* ssq; const float* qg; const float* kg; float* af; const float* lbt; const float* ogn;
    static constexpr size_t MiB = 1u << 20;
    static constexpr int VM_OPS = 0;
    __device__ __forceinline__ void prefetch(const Unit& u, int par, PG8_LAS unsigned char* hi, int wid, int lane) const { prefetch_ssq(ssq, u, par, hi, wid, lane); }
    static constexpr size_t O_Q = 0, O_K = 16 * MiB, O_V = 32 * MiB, O_HQ = 48 * MiB, O_HF = 80 * MiB, O_HI = 144 * MiB, O_HG = 176 * MiB, O_SU = 208 * MiB;
    __device__ __forceinline__ void operator()(const f32x4 (&acc)[2][2][4][2], const Unit& u, int wr, int wc, int fr_, int fq_, const PG8_LAS unsigned char* slot) const {
        int fr = fr_, fq = fq_; asm volatile("" : "+v"(fr), "+v"(fq));
        const int row0 = u.pm * BM + wr * 64 + fr; const int pn = u.pn;
        PG8_RSTD8(r8, slot, fr);
        if (pn < 2) {
            bf16_t* dst = (bf16_t*)(R + (pn == 0 ? O_Q : O_K)); const float* gn = pn == 0 ? qg : kg; const float sc = pn == 0 ? 0.125f * 1.4426950408889634f : 1.0f;
            f32x4 gv[2][2];
#pragma unroll
            for (int bj = 0; bj < 2; ++bj)
#pragma unroll
                for (int n = 0; n < 2; ++n) gv[bj][n] = *(const f32x4*)(gn + 32 * bj + 8 * fq + 4 * n) * sc;
#pragma unroll
            for (int ai = 0; ai < 2; ++ai)
#pragma unroll
                for (int m = 0; m < 4; ++m) { const int row = row0 + ai * HALF + m * 16; const float r = r8[ai][m]; float ss = 0.f; f32x4 v[2][2];
#pragma unroll
                    for (int bj = 0; bj < 2; ++bj)
#pragma unroll
                        for (int n = 0; n < 2; ++n) { v[bj][n] = acc[ai][bj][m][n] * r; const f32x4 x = v[bj][n]; ss += (x[0] * x[0] + x[1] * x[1]) + (x[2] * x[2] + x[3] * x[3]); }
                    ss += __shfl_xor(ss, 16); ss += __shfl_xor(ss, 32);
                    const float hr = __builtin_amdgcn_rsqf(ss * (1.0f / 64.0f) + RMS_EPS);
#pragma unroll
                    for (int bj = 0; bj < 2; ++bj) { const f32x4 a = v[bj][0] * hr * gv[bj][0], b = v[bj][1] * hr * gv[bj][1];
                        u32x4 w; w.x = cvt_pk_bf16(a[0], a[1]); w.y = cvt_pk_bf16(a[2], a[3]); w.z = cvt_pk_bf16(b[0], b[1]); w.w = cvt_pk_bf16(b[2], b[3]);
                        *(u32x4*)(dst + (size_t)row * 256 + 64 * wc + 32 * bj + 8 * fq) = w; } asm volatile("" ::: "memory"); }
        } else if (pn == 12) {
            if (wc == 0 && fq == 0) {
#pragma unroll
                for (int ai = 0; ai < 2; ++ai)
#pragma unroll
                    for (int m = 0; m < 4; ++m) { const int row = row0 + ai * HALF + m * 16; const float r = r8[ai][m]; *(f32x4*)(af + (size_t)row * 4) = acc[ai][0][m][0] * r; asm volatile("" ::: "memory"); } }
        } else if (pn == 5 || pn == 6) {
            float* dst = (float*)(R + O_HF) + (pn - 5) * 256 + wc * 32 + 8 * fq;
            f32x4 lb4[2][2];
#pragma unroll
            for (int bj = 0; bj < 2; ++bj)
#pragma unroll
                for (int n = 0; n < 2; ++n) lb4[bj][n] = *(const f32x4*)(lbt + (pn - 5) * 256 + wc * 32 + 8 * fq + bj * HALF + 4 * n);
#pragma unroll
            for (int ai = 0; ai < 2; ++ai)
#pragma unroll
                for (int m = 0; m < 4; ++m) { const int row = row0 + ai * HALF + m * 16; const float r = r8[ai][m];
#pragma unroll
                    for (int bj = 0; bj < 2; ++bj)
#pragma unroll
                        for (int n = 0; n < 2; ++n) { const f32x4 x = acc[ai][bj][m][n] * r; const f32x4 lb = lb4[bj][n]; f32x4 g;
#pragma unroll
                            for (int i = 0; i < 4; ++i) g[i] = lb[i] + (1.0f - lb[i]) * sigmoid_f(x[i]);
                            *(f32x4*)(dst + (size_t)row * 512 + bj * HALF + 4 * n) = g; } asm volatile("" ::: "memory"); }
        } else {
            size_t ob; int pitch, cb;
            if (pn == 2) { ob = O_V; pitch = 256; cb = 0; } else if (pn <= 4) { ob = O_HQ; pitch = 512; cb = (pn - 3) * 256; } else if (pn <= 8) { ob = O_HI; pitch = 512; cb = (pn - 7) * 256; }
            else if (pn <= 10) { ob = O_HG; pitch = 512; cb = (pn - 9) * 256; } else { ob = O_SU; pitch = 16; cb = 0; }
            bf16_t* dst = (bf16_t*)(R + ob) + cb + wc * 32 + 8 * fq;
            if (pn == 11) dst = (bf16_t*)(R + ob) + (size_t)(2 * wc + (fq >> 1)) * ((size_t)32768 * 16) + 8 * (fq & 1);
#pragma unroll
            for (int ai = 0; ai < 2; ++ai)
#pragma unroll
                for (int m = 0; m < 4; ++m) { const int row = row0 + ai * HALF + m * 16; const float r = r8[ai][m];
#pragma unroll
                    for (int bj = 0; bj < 2; ++bj) { f32x4 a = acc[ai][bj][m][0] * r, b = acc[ai][bj][m][1] * r;
                        if (pn == 9 || pn == 10) {
                            const f32x4 ga = *(const f32x4*)(ogn + (pn - 9) * 256 + wc * 32 + 8 * fq + bj * HALF), gb = *(const f32x4*)(ogn + (pn - 9) * 256 + wc * 32 + 8 * fq + bj * HALF + 4);
#pragma unroll
                            for (int i = 0; i < 4; ++i) { a[i] = silu_f(a[i]) * ga[i]; b[i] = silu_f(b[i]) * gb[i]; } }
                        u32x4 w; w.x = cvt_pk_bf16(a[0], a[1]); w.y = cvt_pk_bf16(a[2], a[3]); w.z = cvt_pk_bf16(b[0], b[1]); w.w = cvt_pk_bf16(b[2], b[3]);
                        *(u32x4*)(dst + (size_t)row * pitch + (pn == 11 ? (size_t)bj * 8 * ((size_t)32768 * 16) : (size_t)(bj * HALF))) = w; } asm volatile("" ::: "memory"); }
        }
    }
};

struct EpiGlu {
    static constexpr bool PERM = true, AFTER_DRAIN = false;
    const bf16_t* z; const float* b; bf16_t* mix;
    static constexpr int VM_OPS = 0;
    __device__ __forceinline__ void prefetch(const Unit&, int, PG8_LAS unsigned char*, int, int) const {}
    __device__ __forceinline__ void operator()(const f32x4 (&acc)[2][2][4][2], const Unit& u, int wr, int wc, int fr_, int fq_, const PG8_LAS unsigned char* slot) const {
        int fr = fr_, fq = fq_; asm volatile("" : "+v"(fr), "+v"(fq));
        const int row0 = u.pm * BM + wr * 64 + fr, col0 = u.pn * BM + wc * 32 + 8 * fq;
        f32x4 bv[2][2];
#pragma unroll
        for (int bj = 0; bj < 2; ++bj)
#pragma unroll
            for (int n = 0; n < 2; ++n) bv[bj][n] = *(const f32x4*)(b + col0 + bj * HALF + 4 * n);
#pragma unroll
        for (int ai = 0; ai < 2; ++ai)
#pragma unroll
            for (int m = 0; m < 4; ++m) { const int row = row0 + ai * HALF + m * 16;
#pragma unroll
                for (int bj = 0; bj < 2; ++bj) { const u32x4 zz = *(const u32x4*)(z + (size_t)row * 256 + col0 + bj * HALF);
                    const f32x4 a = acc[ai][bj][m][0] + bv[bj][0], c = acc[ai][bj][m][1] + bv[bj][1];
                    const float z0 = __uint_as_float(zz.x << 16), z1 = __uint_as_float(zz.x & 0xffff0000u), z2 = __uint_as_float(zz.y << 16), z3 = __uint_as_float(zz.y & 0xffff0000u);
                    const float z4 = __uint_as_float(zz.z << 16), z5 = __uint_as_float(zz.z & 0xffff0000u), z6 = __uint_as_float(zz.w << 16), z7 = __uint_as_float(zz.w & 0xffff0000u);
                    u32x4 w; w.x = cvt_pk_bf16(z0 * sigmoid_f(a[0]), z1 * sigmoid_f(a[1])); w.y = cvt_pk_bf16(z2 * sigmoid_f(a[2]), z3 * sigmoid_f(a[3]));
                    w.z = cvt_pk_bf16(z4 * sigmoid_f(c[0]), z5 * sigmoid_f(c[1])); w.w = cvt_pk_bf16(z6 * sigmoid_f(c[2]), z7 * sigmoid_f(c[3]));
                    *(u32x4*)(mix + (size_t)row * 1024 + 768 + col0 + bj * HALF) = w; asm volatile("" ::: "memory"); } }
    }
};
template <class Epi, class Sched, bool ALIGN_EPI = false, bool SP2 = false>
__device__ __forceinline__ void gemm_phase(PG8_LAS unsigned char* lds, const Gemm g, const Sched& S, const Epi& E) {
    int tid_ = threadIdx.x; asm volatile("" : "+v"(tid_));
    const int tid = tid_, wid = __builtin_amdgcn_readfirstlane(tid >> 6), lane = tid & 63, wr = wid >> 2, wc = wid & 3, fr = lane & 15, fq = lane >> 4;
    int K_ = g.K; asm volatile("" : "+s"(K_));
    const int K = K_, nt = K / BK;
    unsigned voffA[2], voffB[2];
#pragma unroll
    for (int i = 0; i < 2; ++i) { int R, C; stage_rc(tid * 16 + i * 8192, R, C); const int Rb = Epi::PERM ? ((R & ~31) + perm32(R & 31)) : R;
        voffA[i] = (unsigned)(R * K + C) * 2u; voffB[i] = (unsigned)(Rb * K + C) * 2u; }
    const size_t kstep = (size_t)(BK * 2);
    const size_t hstep = (size_t)HALF * K * 2;
    const size_t tstep = 2 * hstep;
    const unsigned ldsw = (unsigned)wid * 1024u;
    const int aoff = lds_byte(wr * 64 + fr, fq * 8), boff = lds_byte(wc * 32 + fr, fq * 8);
#define PG8_SA(b, h) (((b) * 2 + (h)) * HTB)
#define PG8_SB(b, h) ((4 + (b) * 2 + (h)) * HTB)
#define PG8_STAGE(bufoff, gbase, voff) do { _Pragma("unroll") for (int _i = 0; _i < 2; ++_i) \
        __builtin_amdgcn_global_load_lds((const unsigned*)((const char*)(gbase) + (voff)[_i]), (PG8_LAS unsigned*)(lds + (bufoff) + ldsw + _i * 8192), 16, 0, 0); } while (0)
#define PG8_LDA(dst, b, h) do { _Pragma("unroll") for (int m = 0; m < 4; ++m) _Pragma("unroll") for (int k = 0; k < 2; ++k) dst[m][k] = *(const PG8_LAS bf16x8*)(lds + PG8_SA(b, h) + aoff + m * 2048 + k * 1024); } while (0)
#define PG8_LDB(dst, b, h) do { _Pragma("unroll") for (int n = 0; n < 2; ++n) _Pragma("unroll") for (int k = 0; k < 2; ++k) dst[n][k] = *(const PG8_LAS bf16x8*)(lds + PG8_SB(b, h) + boff + n * 2048 + k * 1024); } while (0)
#define PG8_MMA(ai, bj, At, Bt) do { __builtin_amdgcn_s_setprio(1); _Pragma("unroll") for (int m = 0; m < 4; ++m) _Pragma("unroll") for (int n = 0; n < 2; ++n) _Pragma("unroll") for (int k = 0; k < 2; ++k) \
        acc[ai][bj][m][n] = __builtin_amdgcn_mfma_f32_16x16x32_bf16(Bt[n][k], At[m][k], acc[ai][bj][m][n], 0, 0, 0); __builtin_amdgcn_s_setprio(0); } while (0)
#define PG8_WAIT_V(n) asm volatile("s_waitcnt vmcnt(" #n ")" ::: "memory")
#define PG8_WAIT_V8X(rl) asm volatile("s_cmp_lg_u32 %0, 0\n\ts_cbranch_scc1 .Lpg8w%=\n\ts_waitcnt vmcnt(8)\n.Lpg8w%=:\n\ts_waitcnt vmcnt(%1)" :: "s"(rl), "n"(10 + Epi::VM_OPS) : "scc", "memory")
#define PG8_WAIT_L(n) asm volatile("s_waitcnt lgkmcnt(" #n ")" ::: "memory")
#define PG8_BAR __builtin_amdgcn_s_barrier()
#define PG8_SCHED __builtin_amdgcn_sched_barrier(0)
    Unit cur, nxt; int ui = 0;
    if (!S.next(0, cur)) return;
    f32x4 acc[2][2][4][2];
    float zf_ = 0.f; asm volatile("" : "+v"(zf_));
#pragma unroll
    for (int a = 0; a < 2; ++a)
#pragma unroll
        for (int b = 0; b < 2; ++b)
#pragma unroll
            for (int m = 0; m < 4; ++m)
#pragma unroll
                for (int n = 0; n < 2; ++n) acc[a][b][m][n] = (f32x4){zf_, zf_, zf_, zf_};
    bf16x8 At[4][2], B0[2][2], B1[2][2];
    const char* cA = (const char*)g.A + (size_t)cur.pm * tstep; const char* cB = (const char*)g.Bt + (size_t)cur.pn * tstep;
    S.a_ready(cur);
    E.prefetch(cur, 0, lds + STAGE_BYTES, wid, lane);
    if constexpr (SP2) {
        PG8_STAGE(PG8_SB(0, 0), cB, voffB); PG8_STAGE(PG8_SB(0, 1), cB + hstep, voffB); PG8_STAGE(PG8_SA(0, 0), cA, voffA); PG8_STAGE(PG8_SA(0, 1), cA + hstep, voffA);
        if (wr == 1) PG8_BAR;
        PG8_WAIT_V(2); PG8_BAR;
        PG8_STAGE(PG8_SB(1, 0), cB + kstep, voffB); PG8_STAGE(PG8_SA(1, 0), cA + kstep, voffA); PG8_STAGE(PG8_SB(1, 1), cB + hstep + kstep, voffB);
        PG8_WAIT_V(6); PG8_BAR;
    } else {
        PG8_STAGE(PG8_SB(0, 0), cB, voffB); PG8_STAGE(PG8_SA(0, 0), cA, voffA); PG8_STAGE(PG8_SB(0, 1), cB + hstep, voffB); PG8_STAGE(PG8_SA(0, 1), cA + hstep, voffA);
        if (wr == 1) PG8_BAR;
        PG8_WAIT_V(4); PG8_BAR;
        PG8_STAGE(PG8_SB(1, 0), cB + kstep, voffB); PG8_STAGE(PG8_SA(1, 0), cA + kstep, voffA); PG8_STAGE(PG8_SB(1, 1), cB + hstep + kstep, voffB);
        PG8_WAIT_V(6); PG8_BAR;
    }
    for (;;) {
        const bool has_next = S.next(ui + 1, nxt);
        const char* nA = has_next ? (const char*)g.A + (size_t)nxt.pm * tstep : cA; const char* nB = has_next ? (const char*)g.Bt + (size_t)nxt.pn * tstep : cB;
        for (int t = 0; t < nt; t += 2) {
            const bool last = (t == nt - 2);
            const char* a1 = cA + (size_t)(t + 1) * kstep;
            const char* a2 = last ? nA : cA + (size_t)(t + 2) * kstep; const char* b2 = last ? nB : cB + (size_t)(t + 2) * kstep;
            const char* a3 = a2 + kstep; const char* b3 = b2 + kstep;
            if (last && has_next) { S.a_ready(nxt); E.prefetch(nxt, (ui + 1) & 1, lds + STAGE_BYTES, wid, lane); }
            if constexpr (SP2) {
            const int rl = __builtin_amdgcn_readfirstlane((t == 0 && ui > 0) ? 1 : 0);
            PG8_LDB(B0, 0, 0); PG8_LDB(B1, 0, 1); PG8_SCHED; PG8_LDA(At, 0, 0); PG8_STAGE(PG8_SA(1, 1), a1 + hstep, voffA);
            PG8_WAIT_V8X(rl); PG8_WAIT_L(0); PG8_BAR; PG8_MMA(0, 0, At, B0); PG8_MMA(0, 1, At, B1); PG8_BAR; PG8_SCHED;
            PG8_LDA(At, 0, 1); PG8_STAGE(PG8_SB(0, 0), b2, voffB); PG8_STAGE(PG8_SB(0, 1), b2 + hstep, voffB); PG8_STAGE(PG8_SA(0, 0), a2, voffA);
            PG8_WAIT_V8X(rl); PG8_WAIT_L(0); PG8_BAR; PG8_MMA(1, 0, At, B0); PG8_MMA(1, 1, At, B1); PG8_BAR; PG8_SCHED;
            PG8_LDB(B0, 1, 0); PG8_LDB(B1, 1, 1); PG8_SCHED; PG8_LDA(At, 1, 0); PG8_STAGE(PG8_SA(0, 1), a2 + hstep, voffA);
            PG8_WAIT_V8X(rl); PG8_WAIT_L(0); PG8_BAR; PG8_MMA(0, 0, At, B0); PG8_MMA(0, 1, At, B1); PG8_BAR; PG8_SCHED;
            PG8_LDA(At, 1, 1); PG8_STAGE(PG8_SB(1, 0), b3, voffB); PG8_STAGE(PG8_SB(1, 1), b3 + hstep, voffB); PG8_STAGE(PG8_SA(1, 0), a3, voffA);
            PG8_WAIT_V(8); PG8_WAIT_L(0); PG8_BAR; PG8_MMA(1, 0, At, B0); PG8_MMA(1, 1, At, B1); PG8_BAR; PG8_SCHED;
            } else {
            PG8_LDB(B0, 0, 0); PG8_SCHED; PG8_LDA(At, 0, 0); PG8_STAGE(PG8_SA(1, 1), a1 + hstep, voffA);
            PG8_WAIT_L(8); PG8_BAR; PG8_WAIT_L(0); PG8_MMA(0, 0, At, B0); PG8_BAR; PG8_SCHED;
            PG8_LDB(B1, 0, 1); PG8_STAGE(PG8_SB(0, 0), b2, voffB);
            PG8_BAR; PG8_WAIT_L(0); PG8_MMA(0, 1, At, B1); PG8_BAR;
            PG8_LDA(At, 0, 1); PG8_STAGE(PG8_SA(0, 0), a2, voffA);
            PG8_BAR; PG8_WAIT_L(0); PG8_MMA(1, 0, At, B0); PG8_BAR; PG8_SCHED;
            PG8_STAGE(PG8_SB(0, 1), b2 + hstep, voffB);
            PG8_WAIT_V(6); PG8_BAR; PG8_MMA(1, 1, At, B1); PG8_BAR;
            PG8_LDB(B0, 1, 0); PG8_SCHED; PG8_LDA(At, 1, 0); PG8_STAGE(PG8_SA(0, 1), a2 + hstep, voffA);
            PG8_WAIT_L(8); PG8_BAR; PG8_WAIT_L(0); PG8_MMA(0, 0, At, B0); PG8_BAR; PG8_SCHED;
            PG8_LDB(B1, 1, 1); PG8_STAGE(PG8_SB(1, 0), b3, voffB);
            PG8_BAR; PG8_WAIT_L(0); PG8_MMA(0, 1, At, B1); PG8_BAR;
            PG8_LDA(At, 1, 1); PG8_STAGE(PG8_SA(1, 0), a3, voffA);
            PG8_BAR; PG8_WAIT_L(0); PG8_MMA(1, 0, At, B0); PG8_BAR; PG8_SCHED;
            PG8_STAGE(PG8_SB(1, 1), b3 + hstep, voffB);
            PG8_WAIT_V(6); PG8_BAR; PG8_MMA(1, 1, At, B1); PG8_BAR;
            }
        }
        if constexpr (ALIGN_EPI) { if (wr == 0) PG8_BAR; }
        if constexpr (SP2) { if (has_next) PG8_STAGE(PG8_SA(1, 1), nA + kstep + hstep, voffA); }
        if constexpr (!Epi::AFTER_DRAIN) { E(acc, cur, wr, wc, fr, fq, lds + STAGE_BYTES + ((ui & 1) * 8 + wid) * 1024); S.done(cur); }
        if (!has_next) break;
        asm volatile("" : "+v"(zf_));
#pragma unroll
        for (int a = 0; a < 2; ++a)
#pragma unroll
            for (int b = 0; b < 2; ++b)
#pragma unroll
                for (int m = 0; m < 4; ++m)
#pragma unroll
                    for (int n = 0; n < 2; ++n) acc[a][b][m][n] = (f32x4){zf_, zf_, zf_, zf_};
        cur = nxt; cA = nA; cB = nB; ++ui;
        if constexpr (ALIGN_EPI) { if (wr == 1) PG8_BAR; }
    }
    PG8_WAIT_V(0);
    if constexpr (!ALIGN_EPI) { if (wr == 0) PG8_BAR; }
    PG8_BAR;
    if constexpr (Epi::AFTER_DRAIN) { E.fused(acc, cur, wr, wc, fr, fq, lds, wid, lane); S.done(cur); }
#undef PG8_SA
#undef PG8_SB
#undef PG8_STAGE
#undef PG8_LDA
#undef PG8_LDB
#undef PG8_MMA
#undef PG8_WAIT_V
#undef PG8_WAIT_L
#undef PG8_BAR
#undef PG8_SCHED
}
}
#include <hip/hip_bf16.h>
#include <cmath>
namespace attn_body {
using bf16=__hip_bfloat16;
using bf16x8=__attribute__((ext_vector_type(8)))short;
using s16x4=__attribute__((ext_vector_type(4)))short;
using f32x16=__attribute__((ext_vector_type(16)))float;
using u32x4=__attribute__((ext_vector_type(4)))unsigned;
using f32x4v=__attribute__((ext_vector_type(4)))float;
constexpr int BATCH=16,NHEAD=4,SEQ=2048,D=64,DM=NHEAD*D,OPITCH=1024;
constexpr int NW=8,QBLK=32,QB=QBLK*NW,KVBLK=64,NQB=SEQ/QB;
constexpr int ATTN_PITCH=DM, ATTN_UNIT_ROWS=QB;
__device__ __forceinline__ int crow(int r,int hi){return (r&3)+8*(r>>2)+4*hi;}
#define SBAR() __builtin_amdgcn_sched_barrier(0)
__device__ __forceinline__ void cmask(f32x16&p0,f32x16&p1,int jb,int qrel,int hi){
  const float NEG=-INFINITY; int kb=64*jb+4*hi;
  #pragma unroll
  for(int r=0;r<16;++r){int kv=kb+(r&3)+8*(r>>2); if(kv>qrel)p0[r]=NEG; if(kv+32>qrel)p1[r]=NEG;}
}

constexpr int NSLOT=3, SLOTB=8192;
constexpr int LDS_K=0, LDS_V=NSLOT*SLOTB, LDS_WS=2*NSLOT*SLOTB, LDS_OST=LDS_WS+NW*64*4, LDS_BYTES=LDS_OST+NW*4096;
constexpr float C2=0.125f*1.4426950408889634f;
__device__ __forceinline__ void glds16(const void*gsrc,unsigned lds_dst){unsigned keep;
  asm volatile("s_mov_b32 %0, m0\n\ts_mov_b32 m0, %2\n\ts_nop 0\n\tglobal_load_lds_dwordx4 %1, off\n\ts_mov_b32 m0, %0":"=&s"(keep):"v"(gsrc),"s"(lds_dst):"memory");}
__device__ __forceinline__ float max3f(float a,float b,float c){float r;asm("v_max3_f32 %0, %1, %2, %3":"=v"(r):"v"(a),"v"(b),"v"(c));return r;}
__device__ __forceinline__ float max2f(float a,float b){float r;asm("v_max_f32_e32 %0, %1, %2":"=v"(r):"v"(a),"v"(b));return r;}
__device__ __forceinline__ float fadd_s(float a,float b){float r;asm("v_add_f32_e32 %0, %1, %2":"=v"(r):"v"(a),"v"(b));return r;}
__device__ __forceinline__ float fsub_s(float a,float b){float r;asm("v_sub_f32_e32 %0, %1, %2":"=v"(r):"v"(a),"v"(b));return r;}
typedef float f32x2_t __attribute__((ext_vector_type(2))); typedef __bf16 bf16x2_t __attribute__((ext_vector_type(2)));
__device__ __forceinline__ unsigned cvtpk_s(float lo,float hi){f32x2_t v={lo,hi};bf16x2_t b=__builtin_convertvector(v,bf16x2_t);return __builtin_bit_cast(unsigned,b);}
#define WAIT_BAR(N) asm volatile("s_waitcnt vmcnt(" #N ") lgkmcnt(0)\n\ts_barrier":::"memory")

__device__ __forceinline__ void qkt(f32x16&p0,f32x16&p1,const char*Kslot,const bf16x8*qr,int r32,int hi){
  const char*kb=Kslot+hi*1024+r32*16;
  #pragma unroll
  for(int d0=0;d0<4;++d0){
    const bf16x8 b0=*reinterpret_cast<const bf16x8*>(kb+d0*2048);
    const bf16x8 b1=*reinterpret_cast<const bf16x8*>(kb+d0*2048+512);
    p0=__builtin_amdgcn_mfma_f32_32x32x16_bf16(b0,qr[d0],p0,0,0,0);p1=__builtin_amdgcn_mfma_f32_32x32x16_bf16(b1,qr[d0],p1,0,0,0);}
}
typedef __attribute__((address_space(3))) const char* lds_cptr;
typedef short v4i16_t __attribute__((ext_vector_type(4)));
__device__ __forceinline__ void kload8(bf16x8*kf,lds_cptr kp){
  kf[0]=*(const __attribute__((address_space(3))) bf16x8*)(kp);      kf[1]=*(const __attribute__((address_space(3))) bf16x8*)(kp+512);
  kf[2]=*(const __attribute__((address_space(3))) bf16x8*)(kp+2048); kf[3]=*(const __attribute__((address_space(3))) bf16x8*)(kp+2560);
  kf[4]=*(const __attribute__((address_space(3))) bf16x8*)(kp+4096); kf[5]=*(const __attribute__((address_space(3))) bf16x8*)(kp+4608);
  kf[6]=*(const __attribute__((address_space(3))) bf16x8*)(kp+6144); kf[7]=*(const __attribute__((address_space(3))) bf16x8*)(kp+6656);
}
__device__ __forceinline__ void kload2(bf16x8*kf,lds_cptr kp,int j){ kf[2*j]=*(const __attribute__((address_space(3))) bf16x8*)(kp+j*2048); kf[2*j+1]=*(const __attribute__((address_space(3))) bf16x8*)(kp+j*2048+512); }
__device__ __forceinline__ s16x4 vtr(lds_cptr p){ return __builtin_bit_cast(s16x4,__builtin_amdgcn_ds_read_tr16_b64_v4i16((__attribute__((address_space(3))) v4i16_t*)p)); }
__device__ __forceinline__ float rowmax(const f32x16&p0,const f32x16&p1){
  float a=max3f(p0[0],p0[1],p1[0]),b=max3f(p0[2],p0[3],p1[1]);a=max3f(a,p1[2],p1[3]);
  #pragma unroll
  for(int r=4;r<16;r+=4){a=max3f(a,p0[r],p0[r+1]);b=max3f(b,p0[r+2],p0[r+3]);a=max3f(a,p1[r],p1[r+1]);b=max3f(b,p1[r+2],p1[r+3]);}
  const float m=max2f(a,b);
  auto rr=__builtin_amdgcn_permlane32_swap(__float_as_uint(m),__float_as_uint(m),false,false);
  return max2f(__uint_as_float(rr[0]),__uint_as_float(rr[1]));
}
__device__ __forceinline__ void pv(f32x16*o,int vb,bf16x8 pa0,bf16x8 pa1,bf16x8 pa2,bf16x8 pa3){
  #pragma unroll
  for(int d0=0;d0<2;++d0){s16x4 lo[4],hi[4];
    #pragma unroll
    for(int ks=0;ks<4;++ks){
      asm volatile("ds_read_b64_tr_b16 %0,%1 offset:%c2":"=&v"(lo[ks]):"v"(vb),"i"(d0*4096+ks*1024):"memory");
      asm volatile("ds_read_b64_tr_b16 %0,%1 offset:%c2":"=&v"(hi[ks]):"v"(vb),"i"(d0*4096+ks*1024+512):"memory");}
    asm volatile("s_waitcnt lgkmcnt(0)":::"memory");SBAR();
    #define PK(k) (bf16x8){lo[k][0],lo[k][1],lo[k][2],lo[k][3],hi[k][0],hi[k][1],hi[k][2],hi[k][3]}
    o[d0]=__builtin_amdgcn_mfma_f32_32x32x16_bf16(pa0,PK(0),o[d0],0,0,0);
    o[d0]=__builtin_amdgcn_mfma_f32_32x32x16_bf16(pa1,PK(1),o[d0],0,0,0);
    o[d0]=__builtin_amdgcn_mfma_f32_32x32x16_bf16(pa2,PK(2),o[d0],0,0,0);
    o[d0]=__builtin_amdgcn_mfma_f32_32x32x16_bf16(pa3,PK(3),o[d0],0,0,0);
    #undef PK
  }
}

#ifndef ATTN_STORE16
#define ATTN_STORE16(p,v) (*(u32x4*)(p)=(v))
#endif
typedef __attribute__((address_space(3))) const float* lds_cfptr;
template<int THRL> __device__ __forceinline__ void attn_unit(int b,int h,int qb,int tskip,const bf16*Q,const bf16*__restrict__ K,const bf16*__restrict__ V,bf16*O,char*shm,lds_cfptr c2s){
  int tid_=threadIdx.x; asm volatile("":"+v"(tid_));
  const int tid=tid_,lane=tid&63,r32=lane&31,hi=lane>>5; const int wid=__builtin_amdgcn_readfirstlane(tid>>6);
  const long rowbase=(long)b*SEQ; const int q0=qb*QB;
  const bf16*Qw=Q+(rowbase+q0+wid*QBLK)*DM+h*D;
  const bf16*Kh=K+(rowbase+(long)tskip*KVBLK)*DM+h*D,*Vh=V+(rowbase+(long)tskip*KVBLK)*DM+h*D;
  const lds_cfptr c2k=c2s+tskip*KVBLK;
  const unsigned lds0=(unsigned)(uintptr_t)shm;
  float*wsf=(float*)(shm+LDS_WS)+wid*64;
  const bf16*ksrc=Kh+(long)lane*DM+wid*8;
  const bf16*vsrc=Vh+(long)(16*(wid&3)+(lane>>2))*DM+(wid>>2)*32+(lane&3)*8;
  const unsigned kdst=lds0+LDS_K+wid*1024, vdst=lds0+LDS_V+wid*1024;
  #define DMA_K(t,slot) glds16(ksrc+(long)(t)*KVBLK*DM,(unsigned)__builtin_amdgcn_readfirstlane(kdst+(slot)))
  #define DMA_V(t,slot) glds16(vsrc+(long)(t)*KVBLK*DM,(unsigned)__builtin_amdgcn_readfirstlane(vdst+(slot)))
  const int vb0=(int)(lds0+LDS_V)+((lane>>4)&1)*32+(lane&3)*8+(4*hi+((lane&15)>>2))*64;
  const char*Kbase=shm+LDS_K; bf16x8 kf[8];
  const lds_cptr shm3=(lds_cptr)shm; const lds_cptr kp0=shm3+LDS_K+hi*1024+r32*16; const lds_cptr vp0=shm3+LDS_V+((lane>>4)&1)*32+(lane&3)*8+(4*hi+((lane&15)>>2))*64;
  const int NT=(q0+QB)/KVBLK-tskip;
  DMA_K(0,0);DMA_V(0,0);DMA_K(1,SLOTB);
  bf16x8 qr[4];
  #pragma unroll
  for(int d0=0;d0<4;++d0)qr[d0]=*reinterpret_cast<const bf16x8*>(&Qw[(long)r32*DM+d0*16+hi*8]);
  float l_reg=0.f;f32x16 o[2];{float z_=0.f;asm volatile("":"+v"(z_));o[0]=(f32x16){z_,z_,z_,z_,z_,z_,z_,z_,z_,z_,z_,z_,z_,z_,z_,z_};o[1]=o[0];}
  const int qrel=wid*QBLK+r32;
  float qm=c2s[q0+qrel];
  #define BIAS(P0,P1,t) do{ const lds_cfptr cb_=c2k+(t)*KVBLK+4*hi; _Pragma("unroll") for(int g_=0;g_<4;++g_){ const f32x4v a_=*(const __attribute__((address_space(3))) f32x4v*)(cb_+8*g_), b_=*(const __attribute__((address_space(3))) f32x4v*)(cb_+32+8*g_); \
      _Pragma("unroll") for(int i_=0;i_<4;++i_){ P0[4*g_+i_]=qm-a_[i_]; P1[4*g_+i_]=qm-b_[i_]; } } }while(0)
  #define CMASK(P0,P1,t) do{int jb_=(t)-(NT-4); if(jb_>=0)cmask(P0,P1,jb_,qrel,hi);}while(0)
  bool resc=false;
  #define START(P0,P1) do{ const float rm=rowmax(P0,P1); resc=false; \
    { const float dl=rm; qm=fsub_s(qm,dl); \
      _Pragma("unroll") for(int r=0;r<16;++r){P0[r]=fsub_s(P0[r],dl);P1[r]=fsub_s(P1[r],dl);} } \
    _Pragma("unroll") for(int r=0;r<16;++r)P0[r]=__builtin_amdgcn_exp2f(P0[r]); }while(0)
  #define RESC() do{ if(resc){ asm volatile("s_waitcnt lgkmcnt(0)":::"memory"); \
      _Pragma("unroll") for(int d_=0;d_<2;++d_) _Pragma("unroll") for(int r=0;r<16;++r)o[d_][r]*=wsf[crow(r,hi)]; } }while(0)
  f32x16 pA0,pA1,pB0,pB1;
  int sl_prev=0,sl_cur=0,sl_next=SLOTB;
  #define ROT() do{sl_prev=sl_cur;sl_cur=sl_next;sl_next=(sl_next==(NSLOT-1)*SLOTB)?0:sl_next+SLOTB;}while(0)
  DMA_K(2,2*SLOTB);
  WAIT_BAR(3);
  BIAS(pA0,pA1,0); qkt(pA0,pA1,Kbase,qr,r32,hi);asm volatile("s_nop 15\n\ts_nop 7":"+v"(pA0),"+v"(pA1));CMASK(pA0,pA1,0);
  START(pA0,pA1);
  _Pragma("unroll") for(int r=0;r<16;++r)pA1[r]=__builtin_amdgcn_exp2f(pA1[r]);
  WAIT_BAR(0);
  DMA_K(3,0);DMA_V(1,SLOTB);
  ROT();
  kload8(kf,kp0+sl_cur);
  WAIT_BAR(2);
  s16x4 vlo[8],vhi[8]; u32x4 pw0,pw1,pw2,pw3;
  #define PKW(P,B) cvtpk_s(P[B],P[B+1])
  #define PAF(k) __builtin_bit_cast(bf16x8,pw##k)
  #define VFR(i) (bf16x8){vlo[i][0],vlo[i][1],vlo[i][2],vlo[i][3],vhi[i][0],vhi[i][1],vhi[i][2],vhi[i][3]}
  #define PIN(x) asm volatile("":"+v"(x))
  #define MX3(a,b,c) __builtin_fmaxf(__builtin_fmaxf((a),(b)),(c))
  #define GAPA(MF,A0,A1,A2,A3,W0,W1,PW) do{ MF; sacc+=A0; sacc+=A1; sacc+=A2; sacc+=A3; PIN(sacc); W0; W1; PIN(PW); SBAR(); }while(0)
  #define EX(v) __builtin_amdgcn_exp2f(v)
  #define GAPB(MF,X,B) do{ MF; X[B]=EX(X[B]); X[B+1]=EX(X[B+1]); X[B+2]=EX(X[B+2]); X[B+3]=EX(X[B+3]); PIN(X); SBAR(); }while(0)
  #define VRD(i) do{ vlo[i]=vtr(vp_+(((i)>>2)*4096+((i)&3)*1024)); vhi[i]=vtr(vp_+(((i)>>2)*4096+((i)&3)*1024+512)); }while(0)
  #define KRD(G,j) do{ if(G){ kload2(kf,kp0+sl_next,j); SBAR(); } }while(0)
  #define STEP(C0,C1,P0,P1,t,GK,GV,GL) do{ SBAR(); BIAS(C0,C1,t); SBAR(); \
    const lds_cptr vp_=vp0+sl_prev; \
    VRD(0); SBAR(); float sacc=(P0[0]+P0[1]); \
    GAPA(C0=__builtin_amdgcn_mfma_f32_32x32x16_bf16(kf[0],qr[0],C0,0,0,0), P0[2],P0[3],P0[4],P0[5],     pw0[0]=PKW(P0,0), pw0[1]=PKW(P0,2), pw0); \
    VRD(4); SBAR(); GAPA(C1=__builtin_amdgcn_mfma_f32_32x32x16_bf16(kf[1],qr[0],C1,0,0,0), P0[6],P0[7],P0[8],P0[9],     pw0[2]=PKW(P0,4), pw0[3]=PKW(P0,6), pw0); \
    VRD(1); SBAR(); GAPA(C0=__builtin_amdgcn_mfma_f32_32x32x16_bf16(kf[2],qr[1],C0,0,0,0),   P0[10],P0[11],P0[12],P0[13], pw1[0]=PKW(P0,8), pw1[1]=PKW(P0,10), pw1); \
    VRD(5); SBAR(); GAPA(C1=__builtin_amdgcn_mfma_f32_32x32x16_bf16(kf[3],qr[1],C1,0,0,0),   P0[14],P0[15],P1[0],P1[1],   pw1[2]=PKW(P0,12),pw1[3]=PKW(P0,14), pw1); \
    VRD(2); SBAR(); GAPA(C0=__builtin_amdgcn_mfma_f32_32x32x16_bf16(kf[4],qr[2],C0,0,0,0),   P1[2],P1[3],P1[4],P1[5],     pw2[0]=PKW(P1,0), pw2[1]=PKW(P1,2), pw2); \
    VRD(6); SBAR(); GAPA(C1=__builtin_amdgcn_mfma_f32_32x32x16_bf16(kf[5],qr[2],C1,0,0,0),   P1[6],P1[7],P1[8],P1[9],     pw2[2]=PKW(P1,4), pw2[3]=PKW(P1,6), pw2); \
    VRD(3); SBAR(); GAPA(C0=__builtin_amdgcn_mfma_f32_32x32x16_bf16(kf[6],qr[3],C0,0,0,0),   P1[10],P1[11],P1[12],P1[13], pw3[0]=PKW(P1,8), pw3[1]=PKW(P1,10), pw3); \
    VRD(7); SBAR(); GAPA(C1=__builtin_amdgcn_mfma_f32_32x32x16_bf16(kf[7],qr[3],C1,0,0,0),   P1[14],P1[15],0.f,0.f,       pw3[2]=PKW(P1,12),pw3[3]=PKW(P1,14), pw3); \
    l_reg+=sacc; \
    if(GK){DMA_K((t)+3,sl_cur);} if(GV){DMA_V((t)+1,sl_next);} \
    CMASK(C0,C1,t); \
    { float a=MX3(C0[0],C0[1],C1[0]),b=MX3(C0[2],C0[3],C1[1]); a=MX3(a,C1[2],C1[3]); \
      _Pragma("unroll") for(int r=4;r<16;r+=4){a=MX3(a,C0[r],C0[r+1]);b=MX3(b,C0[r+2],C0[r+3]);a=MX3(a,C1[r],C1[r+1]);b=MX3(b,C1[r+2],C1[r+3]);} \
      float rm=__builtin_fmaxf(a,b); { auto rr=__builtin_amdgcn_permlane32_swap(__float_as_uint(rm),__float_as_uint(rm),false,false); rm=__builtin_fmaxf(__uint_as_float(rr[0]),__uint_as_float(rr[1])); } \
      resc=false; \
      if(__builtin_expect(__any(rm>(float)THRL),0)){ const float dl=__builtin_fmaxf(rm,0.f); qm-=dl; \
        _Pragma("unroll") for(int r=0;r<16;++r){C0[r]-=dl;C1[r]-=dl;} \
        const float f=__builtin_amdgcn_exp2f(-dl); l_reg*=f; if(hi==0)wsf[r32]=f; resc=true; } } \
    SBAR(); \
    GAPB(o[0]=__builtin_amdgcn_mfma_f32_32x32x16_bf16(PAF(0),VFR(0),o[0],0,0,0), C0,0); \
    GAPB(o[1]=__builtin_amdgcn_mfma_f32_32x32x16_bf16(PAF(0),VFR(4),o[1],0,0,0), C0,4); \
    KRD(GL,0); GAPB(o[0]=__builtin_amdgcn_mfma_f32_32x32x16_bf16(PAF(1),VFR(1),o[0],0,0,0), C0,8); \
    KRD(GL,1); GAPB(o[1]=__builtin_amdgcn_mfma_f32_32x32x16_bf16(PAF(1),VFR(5),o[1],0,0,0), C0,12); \
    KRD(GL,2); GAPB(o[0]=__builtin_amdgcn_mfma_f32_32x32x16_bf16(PAF(2),VFR(2),o[0],0,0,0), C1,0); \
    KRD(GL,3); GAPB(o[1]=__builtin_amdgcn_mfma_f32_32x32x16_bf16(PAF(2),VFR(6),o[1],0,0,0), C1,4); \
    GAPB(o[0]=__builtin_amdgcn_mfma_f32_32x32x16_bf16(PAF(3),VFR(3),o[0],0,0,0), C1,8); \
    GAPB(o[1]=__builtin_amdgcn_mfma_f32_32x32x16_bf16(PAF(3),VFR(7),o[1],0,0,0), C1,12); \
    }while(0)
  int t=1;
  #undef CMASK
  #define CMASK(P0,P1,t) do{}while(0)
  for(;t+5<NT;t+=2){
    STEP(pB0,pB1,pA0,pA1,t,true,true,true);     WAIT_BAR(2); RESC(); ROT();
    STEP(pA0,pA1,pB0,pB1,t+1,true,true,true);   WAIT_BAR(2); RESC(); ROT();
  }
  #undef CMASK
  #define CMASK(P0,P1,t) do{int jb_=(t)-(NT-4); if(jb_>=0)cmask(P0,P1,jb_,qrel,hi);}while(0)
  #define ENDW(tt) do{ if((tt)+3<NT){WAIT_BAR(2);} else if((tt)+2<NT){WAIT_BAR(1);} else {WAIT_BAR(0);} }while(0)
  for(;t+1<NT;t+=2){
    STEP(pB0,pB1,pA0,pA1,t,(t+3<NT),(t+1<NT),(t+1<NT));       ENDW(t);   RESC(); ROT();
    STEP(pA0,pA1,pB0,pB1,t+1,(t+4<NT),(t+2<NT),(t+2<NT));     ENDW(t+1); RESC(); ROT();
  }
  STEP(pB0,pB1,pA0,pA1,NT-1,false,false,false); RESC();
  { float sacc=pB0[0]+pB0[1]; _Pragma("unroll") for(int r=2;r<16;++r)sacc+=pB0[r]; _Pragma("unroll") for(int r=0;r<16;++r)sacc+=pB1[r]; l_reg+=sacc;
    pw0=(u32x4){PKW(pB0,0),PKW(pB0,2),PKW(pB0,4),PKW(pB0,6)};pw1=(u32x4){PKW(pB0,8),PKW(pB0,10),PKW(pB0,12),PKW(pB0,14)};pw2=(u32x4){PKW(pB1,0),PKW(pB1,2),PKW(pB1,4),PKW(pB1,6)};pw3=(u32x4){PKW(pB1,8),PKW(pB1,10),PKW(pB1,12),PKW(pB1,14)};
    SBAR(); pv(o,vb0+sl_cur,PAF(0),PAF(1),PAF(2),PAF(3)); }
  #undef PKW
  #undef PAF
  #undef VFR
  #undef PIN
  #undef MX3
  #undef GAPA
  #undef GAPB
  #undef EX
  #undef VRD
  #undef KRD
  #undef STEP
  #undef ENDW
  {auto rr=__builtin_amdgcn_permlane32_swap(__float_as_uint(l_reg),__float_as_uint(l_reg),false,false);l_reg=__uint_as_float(rr[0])+__uint_as_float(rr[1]);}
  if(hi==0)wsf[32+r32]=l_reg;asm volatile("s_waitcnt lgkmcnt(0)":::"memory");
  float rli[16];
  #pragma unroll
  for(int r=0;r<16;++r)rli[r]=__builtin_amdgcn_rcpf(wsf[32+crow(r,hi)]);
  bf16*Ow=O+(rowbase+q0+wid*QBLK)*OPITCH+h*D;
  { bf16*stg=(bf16*)(shm+LDS_OST)+wid*2048;
    #pragma unroll
    for(int r=0;r<16;++r){const int orow=crow(r,hi);
      #pragma unroll
      for(int d0=0;d0<2;++d0)stg[orow*64+d0*32+r32]=__float2bfloat16(o[d0][r]*rli[r]);}
    asm volatile("s_waitcnt lgkmcnt(0)":::"memory");
    #pragma unroll
    for(int i=0;i<4;++i){const int row=i*8+(lane>>3),ch=lane&7; const u32x4 v=*(const u32x4*)(stg+row*64+ch*8); ATTN_STORE16(Ow+(long)row*OPITCH+ch*8,v);} }
  asm volatile("s_waitcnt lgkmcnt(0)\n\ts_barrier":::"memory");
  #undef DMA_K
  #undef DMA_V
  #undef CMASK
  #undef START
  #undef RESC
  #undef ROT
  #undef BIAS
}
constexpr int ATTN_LDS_BYTES=LDS_BYTES;
#undef SBAR
#undef WAIT_BAR
}

#define LAS __attribute__((address_space(3)))
#define XB_TMO      128
#define XB_XCNT(j)  (256  + 64 * (j))
#define XB_XSUB(j)  (1280 + 64 * (j))
#define XB_XGEN(j)  (2304 + 64 * (j))
#define XB_TOP      3328
#define XB_TOPGEN   3392
#define XCD_BAR_WORDS 3456
#define XB_SPIN_CAP (1u << 22)

__device__ __forceinline__ unsigned xb_ld(unsigned* p)              { return __hip_atomic_load(p, __ATOMIC_RELAXED, __HIP_MEMORY_SCOPE_AGENT); }
__device__ __forceinline__ unsigned xb_add(unsigned* p, unsigned v) { return __hip_atomic_fetch_add(p, v, __ATOMIC_RELAXED, __HIP_MEMORY_SCOPE_AGENT); }
__device__ __forceinline__ unsigned xb_xcc_id() { return (unsigned)__builtin_amdgcn_s_getreg((3 << 11) | 20) & 0xFu; }
#define XB_SPIN(cond, bar) do { unsigned _sp = 0; while (cond) { __builtin_amdgcn_s_sleep(1); \
    if ((++_sp & 255u) == 0u) { if (xb_ld(&(bar)[XB_TMO])) break; if (_sp > XB_SPIN_CAP) { atomicAdd(&(bar)[XB_TMO], 1u); break; } } } } while (0)

struct XcdBarrier {
    unsigned* bar; unsigned x;
    volatile LAS unsigned* st;
};

__device__ __forceinline__ XcdBarrier xcd_barrier_post(unsigned* bar, volatile LAS unsigned* st) {
    XcdBarrier b; b.bar = bar; b.x = xb_xcc_id(); b.st = st;
    if (threadIdx.x == 0) (void)xb_add(&bar[XB_XCNT(b.x)], 1u);
    return b;
}
__device__ __forceinline__ void xcd_barrier_complete(unsigned* bar, unsigned x, unsigned& nloc, unsigned& nx) {
    const unsigned G = gridDim.x * gridDim.y * gridDim.z;
    unsigned sum, cnt, mine, sp = 0u;
    for (;;) {
        sum = 0u; cnt = 0u; mine = 0u;
#pragma unroll
        for (unsigned j = 0; j < 16; ++j) { const unsigned c = xb_ld(&bar[XB_XCNT(j)]); sum += c; cnt += (c > 0u) ? 1u : 0u; mine = (j == x) ? c : mine; }
        if (sum == G) break;
        __builtin_amdgcn_s_sleep(1);
        if ((++sp & 255u) == 0u) { if (xb_ld(&bar[XB_TMO])) break; if (sp > XB_SPIN_CAP) { atomicAdd(&bar[XB_TMO], 1u); break; } }
    }
    nloc = mine > 0u ? mine : 1u; nx = cnt > 0u ? cnt : 1u;
}

__device__ __forceinline__ void xcd_barrier(const XcdBarrier& b) {
    asm volatile("s_waitcnt vmcnt(0)" ::: "memory");
    __syncthreads();
    if (threadIdx.x == 0) {
        unsigned* bar = b.bar;
        __builtin_amdgcn_s_waitcnt(0);
        unsigned nloc = b.st[0], nx = b.st[1];
        if (nloc == 0u) { xcd_barrier_complete(bar, b.x, nloc, nx); b.st[0] = nloc; b.st[1] = nx; }
        const unsigned old = xb_add(&bar[XB_XSUB(b.x)], 1u);
        const unsigned gen = old / nloc;
        if (old + 1u == (gen + 1u) * nloc) {
            __builtin_amdgcn_fence(__ATOMIC_RELEASE, "agent");
            asm volatile("s_waitcnt vmcnt(0)" ::: "memory");
            const unsigned og = xb_add(&bar[XB_TOP], 1u);
            const unsigned tg = og / nx;
            if (og + 1u == (tg + 1u) * nx) xb_add(&bar[XB_TOPGEN], 1u);
            else XB_SPIN(xb_ld(&bar[XB_TOPGEN]) == tg, bar);
            __builtin_amdgcn_fence(__ATOMIC_ACQUIRE, "agent");
            xb_add(&bar[XB_XGEN(b.x)], 1u);
            asm volatile("s_waitcnt vmcnt(0)" ::: "memory");
        } else {
            XB_SPIN(xb_ld(&bar[XB_XGEN(b.x)]) == gen, bar);
            __builtin_amdgcn_fence(__ATOMIC_ACQUIRE, "agent");
            asm volatile("s_waitcnt vmcnt(0)" ::: "memory");
        }
    }
    __syncthreads();
}

constexpr int NWAVES = 8;
constexpr int NB = 16, SEQ = 2048, DM = 1024, M = NB * SEQ, DFF = 2816, NGU = 2 * DFF, NIN = 13 * 256, INW = 3076, DEPTH = 2;
constexpr size_t MiB = 1u << 20;
constexpr size_t WS_CTL = 0, CTL_ZERO_BYTES = 4 * MiB;
constexpr size_t WS_SSQ7 = 1 * MiB;
constexpr size_t WS_W = 4 * MiB, W_LAYER = 42 * MiB;
constexpr size_t OW_GU1 = 0, OW_D1 = 11 * MiB, OW_IN = OW_D1 + 5 * MiB + 512 * 1024, OW_OUT = OW_IN + 6 * MiB + 512 * 1024, OW_GU2 = OW_OUT + 2 * MiB, OW_D2 = OW_GU2 + 11 * MiB, OW_GLU = OW_D2 + 5 * MiB + 512 * 1024;
static_assert(OW_GLU + 128 * 1024 <= W_LAYER, "weights per layer");
constexpr size_t WS_S5T = 88 * MiB;
constexpr size_t WS_XB = 108 * MiB;
constexpr size_t WS_AF = 172 * MiB;
constexpr size_t WS_LBT = 173 * MiB;
constexpr size_t WS_MIX = 174 * MiB;
constexpr size_t WS_ZB = 238 * MiB;
constexpr size_t WS_R = 256 * MiB;
constexpr size_t WS_END = 480 * MiB;
constexpr int CW_BAR = 4096;
constexpr int RING_OFF = 0, RING_BYTES = 131072;
constexpr int LDS_BYTES = 163840;
constexpr int LDSCTL_OFF = LDS_BYTES - 512, MISC_OFF = LDSCTL_OFF + 320;

#define GAS __attribute__((address_space(1)))
typedef unsigned short bf16;
typedef unsigned v4u __attribute__((ext_vector_type(4)));
typedef float f32x4 __attribute__((ext_vector_type(4)));
#define LDS_WAIT() asm volatile("s_waitcnt lgkmcnt(0)" ::: "memory")
__device__ __forceinline__ unsigned f2bf(float f) { unsigned u = __builtin_bit_cast(unsigned, f); return (u + 0x7fffu + ((u >> 16) & 1u)) >> 16; }
typedef float mk_f32x2 __attribute__((ext_vector_type(2))); typedef __bf16 mk_bf16x2 __attribute__((ext_vector_type(2)));
__device__ __forceinline__ unsigned pk2(float lo, float hi) { const mk_f32x2 v = {lo, hi}; return __builtin_bit_cast(unsigned, __builtin_convertvector(v, mk_bf16x2)); }
__device__ __forceinline__ float bf2f(unsigned short b) { return __uint_as_float((unsigned)b << 16); }
__device__ __forceinline__ float wave_sum(float v) {
#pragma unroll
    for (int o = 1; o < 64; o <<= 1) v += __shfl_xor(v, o);
    return v;
}
__device__ __forceinline__ float wave_max(float v) {
#pragma unroll
    for (int o = 1; o < 64; o <<= 1) v = fmaxf(v, __shfl_xor(v, o));
    return v;
}

#define LDS_BARRIER() do { asm volatile("s_waitcnt lgkmcnt(0)" ::: "memory"); __builtin_amdgcn_s_barrier(); asm volatile("" ::: "memory"); } while (0)
__device__ __forceinline__ float opaque_zero() { float z = 0.f; asm volatile("" : "+v"(z)); return z; }
typedef float mk_f32x16 __attribute__((ext_vector_type(16)));
__device__ __forceinline__ mk_f32x16 zero16() { const float z = opaque_zero(); return (mk_f32x16){z, z, z, z, z, z, z, z, z, z, z, z, z, z, z, z}; }
struct Args { const float* in[27]; float* out; unsigned char* ws; };
typedef const __attribute__((address_space(4))) Args* KArgs;
__device__ __forceinline__ KArgs kargs() { KArgs p = (KArgs)__builtin_amdgcn_kernarg_segment_ptr(); asm volatile("" : "+s"(p)); return p; }

struct Frame {
    LAS unsigned char* lds;
    volatile LAS unsigned* MISC;
    unsigned* ctl;
    int tid, lane, wave, G, bx;
    __device__ __forceinline__ void relaunder() { int t = threadIdx.x; asm volatile("" : "+v"(t)); tid = t; lane = t & 63; wave = __builtin_amdgcn_readfirstlane(t >> 6); int b_ = blockIdx.x, g_ = gridDim.x; asm volatile("" : "+s"(b_), "+s"(g_)); bx = b_; G = g_; }
};

__device__ __forceinline__ void tr_item(const float* W, int K, int ldn, int csrc, int ncv, bf16* WT, int rdst, int kb, const float* gain, LAS float* scr, int lane) {
    const int k0 = 64 * kb, n = lane & 31;
    float wv[32];
#pragma unroll
    for (int i = 0; i < 32; ++i) { const int kk = 2 * i + (lane >> 5); wv[i] = (n < ncv) ? W[(size_t)(k0 + kk) * ldn + csrc + n] : 0.f; }
    if (gain) {
#pragma unroll
        for (int i = 0; i < 32; ++i) wv[i] *= gain[k0 + 2 * i + (lane >> 5)]; }
#pragma unroll
    for (int i = 0; i < 32; ++i) scr[(2 * i + (lane >> 5)) * 33 + n] = wv[i];
    LDS_WAIT(); asm volatile("" ::: "memory");
    const int c = lane & 7;
#pragma unroll
    for (int j = 0; j < 4; ++j) { const int nn = (lane >> 3) + 8 * j; const LAS float* s = scr + (8 * c) * 33 + nn;
        v4u o; o.x = pk2(s[0 * 33], s[1 * 33]); o.y = pk2(s[2 * 33], s[3 * 33]); o.z = pk2(s[4 * 33], s[5 * 33]); o.w = pk2(s[6 * 33], s[7 * 33]);
        *(GAS v4u*)(WT + (size_t)(rdst + nn) * K + k0 + 8 * c) = o; }
    LDS_WAIT(); asm volatile("" ::: "memory");
}

constexpr size_t S5T_STRIDE = 573440, S5T_K = 0, S5T_P = 33280, S5T_Q = 33280 + 262144, S5T_L = 33280 + 2 * 262144;
constexpr int S5_TABLE_ITEMS = 160;
__device__ __forceinline__ void s5_table_item(Frame& F, const KArgs Ap, unsigned char* ws, int item) {
    LAS float* Bbr = (LAS float*)F.lds; LAS float* Bbi = Bbr + 1024; LAS float* Cr = Bbi + 1024; LAS float* Ci = Cr + 1024; LAS float* PWr = Ci + 1024; LAS float* PWi = PWr + 65 * 64;
    const int lg = item < 128 ? item >> 2 : item - 128, l = lg >> 4, g = lg & 15; (void)l; (void)g;
    unsigned char* tbl = ws + WS_S5T + (size_t)lg * S5T_STRIDE;
    LAS float* cfl = PWi + 65 * 64;
    if (F.tid < 64) {
        const int p = F.tid; const float dt = expf(Ap->in[14][lg]);
        const float lr = Ap->in[12][lg * 64 + p], li = Ap->in[13][lg * 64 + p];
        const float mag = expf(lr * dt), lbr = mag * cosf(li * dt), lbi = mag * sinf(li * dt), nr = lbr - 1.0f, ni = lbi, den = lr * lr + li * li;
        cfl[2 * p] = (nr * lr + ni * li) / den; cfl[2 * p + 1] = (ni * lr - nr * li) / den;
        double wr = 1.0, wi = 0.0; const double dlr = (double)lbr, dli = (double)lbi;
#pragma unroll 1
        for (int n = 0; n <= 64; ++n) { PWr[n * 64 + p] = (float)wr; PWi[n * 64 + p] = (float)wi; const double t = wr * dlr - wi * dli; wi = wr * dli + wi * dlr; wr = t; }
    }
    for (int e = F.tid; e < 1024; e += 512) { Cr[e] = Ap->in[17][(size_t)lg * 1024 + e]; Ci[e] = Ap->in[18][(size_t)lg * 1024 + e]; }
    __syncthreads();
    for (int e = F.tid; e < 1024; e += 512) { const int p = e >> 4; const float cfr = cfl[2 * p], cfi = cfl[2 * p + 1];
        const float br = Ap->in[15][(size_t)lg * 1024 + e], bi = Ap->in[16][(size_t)lg * 1024 + e];
        Bbr[e] = cfr * br - cfi * bi; Bbi[e] = cfr * bi + cfi * br; }
    __syncthreads();
    if (item < 128) {
        const int q = item & 3; bf16* KT = (bf16*)(tbl + S5T_K);
        for (int e = F.tid; e < 16 * 256; e += 512) { const int tau = 16 * q + (e >> 8), hp = (e >> 4) & 15, h = e & 15; float acc = 0.f;
#pragma unroll 4
            for (int p = 0; p < 64; ++p) { const float wr = PWr[tau * 64 + p], wi = PWi[tau * 64 + p], br = Bbr[p * 16 + h], bi = Bbi[p * 16 + h];
                const float gr = wr * br - wi * bi, gi = wr * bi + wi * br; acc += Cr[hp * 64 + p] * gr - Ci[hp * 64 + p] * gi; }
            KT[(tau + 1) * 256 + hp * 16 + h] = (bf16)f2bf(acc); }
        if (q == 0 && F.tid < 256) KT[F.tid] = 0;
    } else {
        unsigned* P2 = (unsigned*)(tbl + S5T_P); unsigned* Q2 = (unsigned*)(tbl + S5T_Q); float* L = (float*)(tbl + S5T_L);
        for (int e = F.tid; e < 65536; e += 512) { const int n = e >> 9, k2 = e & 511, p = n >> 1, ri = n & 1, j = k2 >> 3, h = (k2 & 7) * 2;
            const float wr = PWr[(63 - j) * 64 + p], wi = PWi[(63 - j) * 64 + p];
            const float g0 = ri ? wr * Bbi[p * 16 + h] + wi * Bbr[p * 16 + h] : wr * Bbr[p * 16 + h] - wi * Bbi[p * 16 + h];
            const float g1 = ri ? wr * Bbi[p * 16 + h + 1] + wi * Bbr[p * 16 + h + 1] : wr * Bbr[p * 16 + h + 1] - wi * Bbi[p * 16 + h + 1];
            P2[e] = pk2(g0, g1); }
        for (int e = F.tid; e < 65536; e += 512) { const int n = e >> 6, p = e & 63, i = n >> 4, hp = n & 15;
            const float wr = PWr[(i + 1) * 64 + p], wi = PWi[(i + 1) * 64 + p], cr = Cr[hp * 64 + p], ci = Ci[hp * 64 + p];
            Q2[e] = pk2(cr * wr - ci * wi, -(cr * wi + ci * wr)); }
        if (F.tid < 64) { L[2 * F.tid] = PWr[64 * 64 + F.tid]; L[2 * F.tid + 1] = PWi[64 * 64 + F.tid]; }
    }
    __syncthreads();
}
constexpr int IT_G = 88 * 16, IT_D = 32 * 44, IT_IN = 104 * 16, IT_OUT = 32 * 16, IT_GLU = 8 * 4;
constexpr int IT_LAYER = 4 * IT_G + 2 * IT_D + IT_IN + IT_OUT + IT_GLU;
__device__ __forceinline__ void conv_layer(Frame& F, int l, int vb, int nvb) {
    F.relaunder(); const KArgs Ap = kargs(); unsigned char* const A_ws = Ap->ws;
#pragma unroll 1
    for (int it = vb; it < 80; it += nvb) s5_table_item(F, Ap, A_ws, it < 64 ? 64 * l + it : 128 + 16 * l + (it - 64));
    { float* lbt = (float*)(A_ws + WS_LBT) + l * 512;
      for (int e = vb * (NWAVES * 64) + F.tid; e < 512; e += nvb * (NWAVES * 64)) { const float x0 = Ap->in[10][e], x1 = Ap->in[10][512 + e]; const float mx = fmaxf(x0, x1), e0 = expf(x0 - mx), e1 = expf(x1 - mx); lbt[e] = l == 0 ? 0.f : e1 / (e0 + e1); } }
    LAS float* scr = (LAS float*)(F.lds + RING_OFF + F.wave * 16384);
    const int gw = vb * NWAVES + F.wave, NGW = nvb * NWAVES;
#pragma unroll 1
    for (int it = gw; it < IT_LAYER; it += NGW) {
        int r = it;
        unsigned char* wl = A_ws + WS_W + (size_t)l * W_LAYER;
        if (r < 4 * IT_G) {
            const int which = r / IT_G; r %= IT_G; const int blk = r / 16, kb = r % 16; const int ffn = which >> 1, isup = which & 1;
            const float* W = Ap->in[ffn ? (isup ? 25 : 24) : (isup ? 3 : 2)] + (size_t)l * DM * DFF; const float* gain = Ap->in[ffn ? 23 : 1] + l * DM;
            const int col = 32 * blk, rdst = 256 * (col / 128) + (col % 128) + 128 * isup;
            tr_item(W, DM, DFF, col, 32, (bf16*)(wl + (ffn ? OW_GU2 : OW_GU1)), rdst, kb, gain, scr, F.lane); continue; }
        r -= 4 * IT_G;
        if (r < 2 * IT_D) { const int ffn = r / IT_D; r %= IT_D; const int blk = r / 44, kb = r % 44;
            tr_item(Ap->in[ffn ? 26 : 4] + (size_t)l * DFF * DM, DFF, DM, 32 * blk, 32, (bf16*)(wl + (ffn ? OW_D2 : OW_D1)), 32 * blk, kb, nullptr, scr, F.lane); continue; }
        r -= 2 * IT_D;
        if (r < IT_IN) { const int blk = r / 16, kb = r % 16; const int tile = blk >> 3, rb = blk & 7; int csrc, ncv = 32;
            if (tile < 2) { const int bj = rb >> 2, wc = rb & 3; csrc = tile * 256 + 32 * (2 * wc + bj); }
            else if (tile == 2) csrc = 512 + 32 * rb;
            else if (tile < 12) csrc = 772 + (tile - 3) * 256 + 32 * rb;
            else { csrc = 768; ncv = rb == 0 ? 4 : 0; }
            tr_item(Ap->in[6] + (size_t)l * DM * INW, DM, INW, csrc, ncv, (bf16*)(wl + OW_IN), tile * 256 + 32 * rb, kb, Ap->in[5] + l * DM, scr, F.lane); continue; }
        r -= IT_IN;
        if (r < IT_OUT) { const int blk = r / 16, kb = r % 16;
            tr_item(Ap->in[22] + (size_t)l * DM * DM, DM, DM, 32 * blk, 32, (bf16*)(wl + OW_OUT), 32 * blk, kb, nullptr, scr, F.lane); continue; }
        r -= IT_OUT;
        { const int blk = r / 4, kb = r % 4;
            tr_item(Ap->in[20] + (size_t)l * 256 * 256, 256, 256, 32 * blk, 32, (bf16*)(wl + OW_GLU), 32 * blk, kb, nullptr, scr, F.lane); }
    }
}
__device__ __forceinline__ void p0_prologue(Frame& F) {
    F.relaunder(); const KArgs Ap = kargs(); unsigned char* const A_ws = Ap->ws;
    const int gw = F.bx * NWAVES + F.wave, NGW = F.G * NWAVES;
    bf16* XB = (bf16*)(A_ws + WS_XB); pg8::ssq_t* SSQ = (pg8::ssq_t*)(A_ws + WS_SSQ7);
    for (int m = gw; m < M; m += NGW) {
        const GAS f32x4* xr = (const GAS f32x4*)(Ap->in[0] + (size_t)m * DM) + F.lane; f32x4 v[4]; float s = 0.f;
#pragma unroll
        for (int j = 0; j < 4; ++j) { v[j] = xr[64 * j]; s += (v[j].x * v[j].x + v[j].y * v[j].y) + (v[j].z * v[j].z + v[j].w * v[j].w); }
        s = wave_sum(s);
        GAS unsigned long long* o8 = (GAS unsigned long long*)(XB + (size_t)m * DM) + F.lane;
#pragma unroll
        for (int j = 0; j < 4; ++j) o8[64 * j] = (unsigned long long)pk2(v[j].x, v[j].y) | ((unsigned long long)pk2(v[j].z, v[j].w) << 32);
        if (F.lane == 0) SSQ[m] = (pg8::ssq_t)(s * pg8::SSQ_SCALE);
    }
}

__device__ __forceinline__ void naive_attn(Frame& F, int l) {
    F.relaunder(); const KArgs Ap = kargs(); unsigned char* const A_ws = Ap->ws;
    LAS float* c2 = (LAS float*)(F.lds); LAS float* wtot = (LAS float*)(F.lds + 8192);
    const bf16* QB = (const bf16*)(A_ws + WS_R + pg8::EpiWin::O_Q); const bf16* KB = (const bf16*)(A_ws + WS_R + pg8::EpiWin::O_K); const bf16* VB = (const bf16*)(A_ws + WS_R + pg8::EpiWin::O_V);
    const float* AF = (const float*)(A_ws + WS_AF); bf16* MIX = (bf16*)(A_ws + WS_MIX);
    const int lane = F.lane;
    for (int u = F.bx; u < 512; u += F.G) {
        const int bh = u & 63, qq = u >> 6, qb = qq < 4 ? qq : 11 - qq, b = bh >> 2, h = bh & 3;
        { const float fb = Ap->in[7][l * 4 + h]; float ls[4]; float run = 0.f;
#pragma unroll
          for (int j = 0; j < 4; ++j) { const float x = AF[(size_t)(b * SEQ + 4 * F.tid + j) * 4 + h] + fb; run += fminf(x, 0.f) - log1pf(expf(-fabsf(x))); ls[j] = run; }
          float inc = run;
#pragma unroll
          for (int o = 1; o < 64; o <<= 1) { const float t = __shfl_up(inc, o); if (lane >= o) inc += t; }
          if (lane == 63) wtot[F.wave] = inc;
          __syncthreads();
          float base = inc - run; for (int w = 0; w < F.wave; ++w) base += wtot[w];
#pragma unroll
          for (int j = 0; j < 4; ++j) c2[4 * F.tid + j] = (base + ls[j]) * 1.4426950408889634f;
          __syncthreads(); }
#pragma unroll 1
        for (int r = F.wave; r < 256; r += NWAVES) {
            const int t = 256 * qb + r; const size_t rowq = (size_t)(b * SEQ + t);
            const float qv = bf2f(QB[rowq * 256 + h * 64 + lane]); const float ct = c2[t];
            float mrun = -INFINITY, lrun = 0.f, o = 0.f;
#pragma unroll 1
            for (int s0 = 0; s0 <= t; s0 += 64) {
                const int s = s0 + lane; const v4u* kp = (const v4u*)(KB + (size_t)(b * SEQ + s) * 256 + h * 64); float acc = 0.f;
#pragma unroll
                for (int c = 0; c < 8; ++c) { const v4u kv = kp[c]; const unsigned w4[4] = {kv.x, kv.y, kv.z, kv.w};
#pragma unroll
                    for (int e = 0; e < 4; ++e) { const float q0 = __int_as_float(__builtin_amdgcn_readlane(__float_as_int(qv), 8 * c + 2 * e)), q1 = __int_as_float(__builtin_amdgcn_readlane(__float_as_int(qv), 8 * c + 2 * e + 1));
                        acc += q0 * __uint_as_float(w4[e] << 16) + q1 * __uint_as_float(w4[e] & 0xffff0000u); } }
                const float logit = (s <= t) ? acc + ct - c2[s] : -INFINITY;
                const float mn = fmaxf(mrun, wave_max(logit)); const float p = __builtin_amdgcn_exp2f(logit - mn), corr = __builtin_amdgcn_exp2f(mrun - mn);
                lrun = lrun * corr + wave_sum(p); o *= corr; mrun = mn;
                const bf16* vp = VB + (size_t)(b * SEQ + s0) * 256 + h * 64 + lane;
#pragma unroll 8
                for (int ss = 0; ss < 64; ++ss) { const float ps = __int_as_float(__builtin_amdgcn_readlane(__float_as_int(p), ss)); o += ps * bf2f(vp[(size_t)ss * 256]); }
            }
            MIX[rowq * 1024 + h * 64 + lane] = (bf16)f2bf(o / lrun);
        }
        __syncthreads();
    }
}
__device__ __forceinline__ void naive_hgrn(Frame& F, int l) {
    F.relaunder(); const KArgs Ap = kargs(); unsigned char* const A_ws = Ap->ws;
    constexpr int TB = 8;
    LAS float* sf = (LAS float*)(F.lds); LAS float* sk = sf + TB * 128; LAS float* sq = sk + TB * 128; LAS float* si = sq + TB * 128; LAS float* sp = si + TB * 128;
    const bf16* HQ = (const bf16*)(A_ws + WS_R + pg8::EpiWin::O_HQ); const float* HF = (const float*)(A_ws + WS_R + pg8::EpiWin::O_HF);
    const bf16* HI = (const bf16*)(A_ws + WS_R + pg8::EpiWin::O_HI); const bf16* HG = (const bf16*)(A_ws + WS_R + pg8::EpiWin::O_HG); bf16* MIX = (bf16*)(A_ws + WS_MIX);
    const int v = F.tid & 127, kq = F.tid >> 7;
    for (int u = F.bx; u < 64; u += F.G) {
        const int b = u >> 2, h = u & 3;
        float S[32];
#pragma unroll
        for (int i = 0; i < 32; ++i) S[i] = 0.f;
        float lbv = 0.f; { const int k = h * 128 + (F.tid & 127); if (l == 1) { const float a0 = Ap->in[10][k], a1 = Ap->in[10][512 + k]; const float mx = fmaxf(a0, a1); const float e0 = expf(a0 - mx), e1 = expf(a1 - mx); lbv = e1 / (e0 + e1); } }
        const float og = Ap->in[11][l * 512 + h * 128 + (F.lane)], og2 = Ap->in[11][l * 512 + h * 128 + 64 + F.lane];
#pragma unroll 1
        for (int t0 = 0; t0 < SEQ; t0 += TB) {
#pragma unroll
            for (int e = 0; e < 2; ++e) { const int idx = F.tid + 512 * e, tok = idx >> 7, k = idx & 127; const size_t row = (size_t)(b * SEQ + t0 + tok);
                const float x = HF[row * 512 + h * 128 + k]; const float sg = 1.0f / (1.0f + expf(-x)); const float f = lbv + (1.0f - lbv) * sg;
                sf[idx] = f; sk[idx] = 1.0f - f; sq[idx] = bf2f(HQ[row * 512 + h * 128 + k]); si[idx] = bf2f(HI[row * 512 + h * 128 + k]); }
            __syncthreads();
#pragma unroll 1
            for (int tok = 0; tok < TB; ++tok) { const float iv = si[tok * 128 + v]; float part = 0.f;
#pragma unroll
                for (int i = 0; i < 32; i += 4) { const f32x4 f4 = *(const LAS f32x4*)(sf + tok * 128 + kq * 32 + i), k4 = *(const LAS f32x4*)(sk + tok * 128 + kq * 32 + i), q4 = *(const LAS f32x4*)(sq + tok * 128 + kq * 32 + i);
#pragma unroll
                    for (int e = 0; e < 4; ++e) { S[i + e] = f4[e] * S[i + e] + k4[e] * iv; part += S[i + e] * q4[e]; } }
                sp[(tok * 4 + kq) * 128 + v] = part; }
            __syncthreads();
            { const int tok = F.wave; const size_t row = (size_t)(b * SEQ + t0 + tok);
              const float o0 = (sp[(tok * 4 + 0) * 128 + F.lane] + sp[(tok * 4 + 1) * 128 + F.lane]) + (sp[(tok * 4 + 2) * 128 + F.lane] + sp[(tok * 4 + 3) * 128 + F.lane]);
              const float o1 = (sp[(tok * 4 + 0) * 128 + 64 + F.lane] + sp[(tok * 4 + 1) * 128 + 64 + F.lane]) + (sp[(tok * 4 + 2) * 128 + 64 + F.lane] + sp[(tok * 4 + 3) * 128 + 64 + F.lane]);
              const float rs = 1.0f / sqrtf(wave_sum(o0 * o0 + o1 * o1) * (1.0f / 128.0f) + 1e-6f);
              const float g0 = bf2f(HG[row * 512 + h * 128 + F.lane]), g1 = bf2f(HG[row * 512 + h * 128 + 64 + F.lane]);
              MIX[row * 1024 + 256 + h * 128 + F.lane] = (bf16)f2bf(o0 * rs * og * (g0 / (1.0f + expf(-g0))));
              MIX[row * 1024 + 256 + h * 128 + 64 + F.lane] = (bf16)f2bf(o1 * rs * og2 * (g1 / (1.0f + expf(-g1)))); }
            __syncthreads();
        }
    }
}
__device__ __forceinline__ void naive_s5(Frame& F, int l) {
    F.relaunder(); const KArgs Ap = kargs(); unsigned char* const A_ws = Ap->ws;
    const bf16* SU = (const bf16*)(A_ws + WS_R + pg8::EpiWin::O_SU); bf16* ZB = (bf16*)(A_ws + WS_ZB);
    const int p = F.lane;
#pragma unroll 1
    for (int u = F.bx; u < 256; u += F.G) {
        const int b = u >> 4, g = u & 15;
        const double lr = (double)Ap->in[12][(l * 16 + g) * 64 + p], li = (double)Ap->in[13][(l * 16 + g) * 64 + p], dt = exp((double)Ap->in[14][l * 16 + g]);
        const double mag = exp(lr * dt), lbr = mag * cos(li * dt), lbi = mag * sin(li * dt), nr = lbr - 1.0, ni = lbi, den = lr * lr + li * li;
        const double cfr = (nr * lr + ni * li) / den, cfi = (ni * lr - nr * li) / den;
        float Br[16], Bi[16];
#pragma unroll
        for (int hh = 0; hh < 16; ++hh) { const double br = (double)Ap->in[15][((size_t)(l * 16 + g) * 64 + p) * 16 + hh], bi = (double)Ap->in[16][((size_t)(l * 16 + g) * 64 + p) * 16 + hh];
            Br[hh] = (float)(cfr * br - cfi * bi); Bi[hh] = (float)(cfr * bi + cfi * br); }
        const int h0 = 2 * F.wave;
        const float c0r = Ap->in[17][((size_t)(l * 16 + g) * 16 + h0) * 64 + p], c0i = Ap->in[18][((size_t)(l * 16 + g) * 16 + h0) * 64 + p];
        const float c1r = Ap->in[17][((size_t)(l * 16 + g) * 16 + h0 + 1) * 64 + p], c1i = Ap->in[18][((size_t)(l * 16 + g) * 16 + h0 + 1) * 64 + p];
        const float d0 = Ap->in[19][l * 256 + g * 16 + h0], d1 = Ap->in[19][l * 256 + g * 16 + h0 + 1];
        const float ar = (float)lbr, ai = (float)lbi; float xr = 0.f, xi = 0.f;
#pragma unroll 1
        for (int t = 0; t < SEQ; ++t) {
            const size_t row = (size_t)(b * SEQ + t); const v4u* up = (const v4u*)(SU + ((size_t)g * M + row) * 16); const v4u ua = up[0], ub = up[1];
            const unsigned w8[8] = {ua.x, ua.y, ua.z, ua.w, ub.x, ub.y, ub.z, ub.w}; float uu[16];
#pragma unroll
            for (int e = 0; e < 8; ++e) { uu[2 * e] = __uint_as_float(w8[e] << 16); uu[2 * e + 1] = __uint_as_float(w8[e] & 0xffff0000u); }
            float bur = 0.f, bui = 0.f;
#pragma unroll
            for (int hh = 0; hh < 16; ++hh) { bur += Br[hh] * uu[hh]; bui += Bi[hh] * uu[hh]; }
            const float nxr = ar * xr - ai * xi + bur, nxi = ar * xi + ai * xr + bui; xr = nxr; xi = nxi;
            float y0 = wave_sum(c0r * xr - c0i * xi), y1 = wave_sum(c1r * xr - c1i * xi);
            float u0 = 0.f, u1 = 0.f;
#pragma unroll
            for (int hh = 0; hh < 16; ++hh) { if (hh == h0) u0 = uu[hh]; if (hh == h0 + 1) u1 = uu[hh]; }
            y0 += d0 * u0; y1 += d1 * u1;
            const float z0 = 0.5f * y0 * (1.0f + tanhf(0.7978845608028654f * (y0 + 0.044715f * y0 * y0 * y0))), z1 = 0.5f * y1 * (1.0f + tanhf(0.7978845608028654f * (y1 + 0.044715f * y1 * y1 * y1)));
            if (p == 0) *(unsigned*)(ZB + row * 256 + g * 16 + h0) = pk2(z0, z1);
        }
    }
}


constexpr int ATT_C2_OFF = 86016;
static_assert(attn_body::ATTN_LDS_BYTES <= ATT_C2_OFF && ATT_C2_OFF + 8192 + 64 <= RING_BYTES, "attention LDS map");
__device__ __forceinline__ void fast_attn(Frame& F, char* ldsg, int l) {
    F.relaunder(); const KArgs Ap = kargs(); unsigned char* const A_ws = Ap->ws;
    LAS float* c2 = (LAS float*)(F.lds + ATT_C2_OFF); LAS float* wtot = (LAS float*)(F.lds + ATT_C2_OFF + 8192);
    const attn_body::bf16* QB = (const attn_body::bf16*)(A_ws + WS_R + pg8::EpiWin::O_Q); const attn_body::bf16* KB = (const attn_body::bf16*)(A_ws + WS_R + pg8::EpiWin::O_K); const attn_body::bf16* VB = (const attn_body::bf16*)(A_ws + WS_R + pg8::EpiWin::O_V);
    const float* AF = (const float*)(A_ws + WS_AF); attn_body::bf16* MIX = (attn_body::bf16*)(A_ws + WS_MIX);
    const int lane = F.lane;
    const float mq = wave_max(fabsf(Ap->in[8][l * 64 + lane])), mk = wave_max(fabsf(Ap->in[9][l * 64 + lane]));
    const float prune_th = 150.0f + 8.0f + 1.0f + 2.0f * 1.02f * (0.125f * 1.4426950408889634f * 64.0f) * mq * mk;
#pragma unroll 1
    for (int v = (F.G == 256 ? F.bx - 64 : F.bx); v >= 0 && v < 192; v += (F.G == 256 ? 192 : F.G)) {
        const int bh = v < 64 ? v : (v - 64) >> 1, sh = v < 64 ? 0 : 1 + ((v - 64) & 1), b = bh >> 2, h = bh & 3;
        { const float fb = Ap->in[7][l * 4 + h]; float ls[4]; float run = 0.f;
#pragma unroll
          for (int j = 0; j < 4; ++j) { const float x = AF[(size_t)(b * SEQ + 4 * F.tid + j) * 4 + h] + fb; run += fminf(x, 0.f) - log1pf(expf(-fabsf(x))); ls[j] = run; }
          float inc = run;
#pragma unroll
          for (int o = 1; o < 64; o <<= 1) { const float t = __shfl_up(inc, o); if (lane >= o) inc += t; }
          if (lane == 63) wtot[F.wave] = inc;
          __syncthreads();
          float base = inc - run; for (int w = 0; w < F.wave; ++w) base += wtot[w];
#pragma unroll
          for (int j = 0; j < 4; ++j) c2[4 * F.tid + j] = (base + ls[j]) * 1.4426950408889634f;
          __syncthreads(); }
        const int nun = sh == 0 ? 1 : sh == 1 ? 3 : 4;
#pragma unroll 1
        for (int i = 0; i < nun; ++i) { const int qb = sh == 0 ? 7 : sh == 1 ? (i == 0 ? 6 : i == 1 ? 5 : 0) : 4 - i;
            int tskip = 4 * qb; const float cq0 = c2[256 * qb];
#pragma unroll 1
            for (; tskip > 0; tskip -= 2) if (c2[64 * tskip - 1] - cq0 > prune_th) break;
            tskip = __builtin_amdgcn_readfirstlane(tskip);
            attn_body::attn_unit<8>(b, h, qb, tskip, QB, KB, VB, MIX, ldsg + RING_OFF, (attn_body::lds_cfptr)c2); }
    }
}

constexpr int S5_KT_OFF = 0, S5_EP_OFF = 50176, S5_XC_OFF = 83968, S5_XC_STRIDE = 272, S5_U_OFF = 92672, S5_U_CH = 2064, S5_END = S5_U_OFF + 32 * S5_U_CH;
static_assert(S5_XC_OFF + 32 * S5_XC_STRIDE <= S5_U_OFF && S5_END <= LDSCTL_OFF, "S5 LDS map");
__device__ __forceinline__ int crow16(int r, int hi) { return (r & 3) + 8 * (r >> 2) + 4 * hi; }
template <int A0> __device__ __forceinline__ void s5_seg(mk_f32x16 (&acc)[4], int j0, int j1, const LAS unsigned char* ul, const LAS unsigned char* kt, const int (&kb)[4]) {
    typedef short bf16x8 __attribute__((ext_vector_type(8)));
#pragma unroll 2
    for (int j = j0; j < j1; ++j) { const bf16x8 af = *(const LAS bf16x8*)(ul + j * 32);
#pragma unroll
        for (int a = A0; a < 4; ++a) { const bf16x8 bfr = *(const LAS bf16x8*)(kt + kb[a] - j * 768); acc[a] = __builtin_amdgcn_mfma_f32_32x32x16_bf16(af, bfr, acc[a], 0, 0, 0); } }
}
__device__ __forceinline__ void fast_s5(Frame& F, int l) {
    F.relaunder(); const KArgs Ap = kargs(); unsigned char* const A_ws = Ap->ws;
    typedef short bf16x8 __attribute__((ext_vector_type(8))); typedef float f32x16 __attribute__((ext_vector_type(16)));
    const bf16* SU = (const bf16*)(A_ws + WS_R + pg8::EpiWin::O_SU); bf16* ZB = (bf16*)(A_ws + WS_ZB);
    const int lane = F.lane, r32 = lane & 31, hi = lane >> 5, w = F.wave;
    LAS unsigned char* kt = F.lds + S5_KT_OFF; LAS float* Ep = (LAS float*)(F.lds + S5_EP_OFF); LAS unsigned char* xc = F.lds + S5_XC_OFF; LAS unsigned char* ui = F.lds + S5_U_OFF;
#pragma unroll 1
    for (int u = (F.G == 256 ? F.bx - 64 : F.bx); u >= 0 && u < 256; u += (F.G == 256 ? 192 : F.G)) {
        const int b = u >> 4, g = u & 15; const unsigned char* tbl = A_ws + WS_S5T + (size_t)(l * 16 + g) * S5T_STRIDE;
        const bf16* Ug = SU + ((size_t)g * M + (size_t)b * SEQ) * 16;
#pragma unroll
        for (int e = 0; e < 8; ++e) { const int pc = F.tid + 512 * e, tok = pc >> 1; const v4u val = *(const v4u*)((const unsigned char*)Ug + (size_t)pc * 16); *(LAS v4u*)(ui + (tok >> 6) * S5_U_CH + (tok & 63) * 32 + (pc & 1) * 16) = val; }
        for (int pc = F.tid; pc < 2080; pc += 512) { const v4u val = *(const v4u*)(tbl + S5T_K + (size_t)pc * 16); *(LAS v4u*)(kt + (pc >> 1) * 48 + (pc & 1) * 16) = val; }
        LDS_BARRIER();
        const LAS unsigned char* ul = ui + r32 * S5_U_CH + 16 * hi;
        {
            const int nt = w & 3, kh = w >> 2;
            const unsigned po = (unsigned)((32 * nt + r32) * 1024 + (32 * kh) * 16 + 8 * hi); const bf16* Pt = (const bf16*)(tbl + S5T_P);
            f32x16 acc = zero16();
#pragma unroll 16
            for (int ks = 0; ks < 32; ++ks) { const bf16x8 a = *(const LAS bf16x8*)(ul + (32 * kh + ks) * 32), bq = *(const bf16x8*)(Pt + (po + ks * 16)); acc = __builtin_amdgcn_mfma_f32_32x32x16_bf16(a, bq, acc, 0, 0, 0); }
#pragma unroll
            for (int r = 0; r < 16; ++r) Ep[(kh * 32 + crow16(r, hi)) * 128 + 32 * nt + r32] = acc[r];
        }
        LDS_BARRIER();
        if (w == 0) {
            const float* L = (const float*)(tbl + S5T_L); const float ar = L[2 * lane], ai = L[2 * lane + 1]; float xr = 0.f, xi = 0.f;
#pragma unroll 4
            for (int c = 0; c < 32; ++c) { *(LAS unsigned*)(xc + c * S5_XC_STRIDE + 4 * lane) = pk2(xr, xi);
                const float er = Ep[c * 128 + 2 * lane] + Ep[(32 + c) * 128 + 2 * lane], ei = Ep[c * 128 + 2 * lane + 1] + Ep[(32 + c) * 128 + 2 * lane + 1];
                const float nxr = ar * xr - ai * xi + er, nxi = ar * xi + ai * xr + ei; xr = nxr; xi = nxi; }
        }
        LDS_BARRIER();
        {
            const int nts[4] = {w, 15 - w, 16 + w, 31 - w}; const int il = r32 >> 4, hp = r32 & 15;
            f32x16 acc[4] = {zero16(), zero16(), zero16(), zero16()};
            int kb[4];
#pragma unroll
            for (int a = 0; a < 4; ++a) kb[a] = ((2 * nts[a] + il + 1) * 16 + hp) * 48 + hi * 16;
            s5_seg<0>(acc, 0, 2 * w + 2, ul, kt, kb); s5_seg<1>(acc, 2 * w + 2, 32 - 2 * w, ul, kt, kb); s5_seg<2>(acc, 32 - 2 * w, 34 + 2 * w, ul, kt, kb); s5_seg<3>(acc, 34 + 2 * w, 64 - 2 * w, ul, kt, kb);
            const bf16* Qt = (const bf16*)(tbl + S5T_Q);
#pragma unroll
            for (int a = 0; a < 4; ++a) { const bf16* qa = Qt + (size_t)((32 * nts[a] + r32) * 128 + 8 * hi); const LAS unsigned char* xa_ = xc + r32 * S5_XC_STRIDE + 16 * hi;
#pragma unroll
                for (int ks = 0; ks < 8; ++ks) { const bf16x8 af = *(const LAS bf16x8*)(xa_ + 32 * ks), bfr = *(const bf16x8*)(qa + 16 * ks); acc[a] = __builtin_amdgcn_mfma_f32_32x32x16_bf16(af, bfr, acc[a], 0, 0, 0); }
                asm volatile("" ::: "memory"); }
            const float dv = Ap->in[19][l * 256 + g * 16 + hp]; bf16* const Zb = ZB + (size_t)b * SEQ * 256;
            int il_ = il, hp_ = hp, hi_ = hi; asm volatile("" : "+v"(il_), "+v"(hp_), "+v"(hi_));
#pragma unroll
            for (int a = 0; a < 4; ++a)
#pragma unroll
                for (int r = 0; r < 16; ++r) { const int c = crow16(r, hi_), i = 2 * nts[a] + il_, t = 64 * c + i;
                    const float y = acc[a][r] + dv * bf2f(*(const LAS unsigned short*)(ui + c * S5_U_CH + i * 32 + hp_ * 2));
                    const float aa = 0.7978845608028654f * (y + 0.044715f * y * y * y); const float z = y * __builtin_amdgcn_rcpf(1.0f + __builtin_amdgcn_exp2f(-2.0f * 1.4426950408889634f * aa));
                    Zb[(unsigned)(t * 256 + g * 16 + hp_)] = (bf16)f2bf(z); }
        }
        LDS_BARRIER();
    }
}

constexpr int HG_RS = 144, HG_QE = 0, HG_QX = 18432, HG_KE = 36864, HG_KX1 = 55296, HG_KX0 = 73728, HG_KX0_RS = 80, HG_I = 83968, HG_X = 100352, HG_ST = 109568, HG_ST_RS = 272,
              HG_OB = 144384, HG_OB_RS = 272, HG_DEC = 161792, HG_END = 162304;
static_assert(HG_END <= LDSCTL_OFF && HG_OB + 64 * HG_OB_RS <= HG_DEC && HG_ST + 128 * HG_ST_RS <= HG_OB, "HGRN LDS map");
typedef short hg_s16x4 __attribute__((ext_vector_type(4)));
__device__ __forceinline__ hg_s16x4 hg_tr(LAS unsigned char* p) { return __builtin_bit_cast(hg_s16x4, __builtin_amdgcn_ds_read_tr16_b64_v4i16((LAS hg_s16x4*)p)); }
__device__ __forceinline__ void hg_epilogue(LAS unsigned char* L, int tid, v4u gt0, v4u gt1, bf16* mp) {
    const int tk = tid >> 3, part = tid & 7; const LAS v4u* op = (const LAS v4u*)(L + HG_OB + tk * HG_OB_RS + part * 32);
    const v4u oa = op[0], ob = op[1]; const unsigned ow[8] = {oa.x, oa.y, oa.z, oa.w, ob.x, ob.y, ob.z, ob.w}; const unsigned gw[8] = {gt0.x, gt0.y, gt0.z, gt0.w, gt1.x, gt1.y, gt1.z, gt1.w};
    float ov[16]; float ss = 0.f;
#pragma unroll
    for (int e = 0; e < 8; ++e) { ov[2 * e] = __uint_as_float(ow[e] << 16); ov[2 * e + 1] = __uint_as_float(ow[e] & 0xffff0000u); ss += ov[2 * e] * ov[2 * e] + ov[2 * e + 1] * ov[2 * e + 1]; }
    ss += __shfl_xor(ss, 1); ss += __shfl_xor(ss, 2); ss += __shfl_xor(ss, 4);
    const float rs = __builtin_amdgcn_rsqf(ss * (1.0f / 128.0f) + 1e-6f); unsigned res[8];
#pragma unroll
    for (int e = 0; e < 8; ++e) { const float ga = __uint_as_float(gw[e] << 16), gb = __uint_as_float(gw[e] & 0xffff0000u);
        res[e] = pk2(ov[2 * e] * rs * ga, ov[2 * e + 1] * rs * gb); }
    *(v4u*)mp = (v4u){res[0], res[1], res[2], res[3]}; *(v4u*)(mp + 8) = (v4u){res[4], res[5], res[6], res[7]};
}
__device__ __forceinline__ void fast_hgrn(Frame& F, int l) {
    F.relaunder(); const KArgs Ap = kargs(); unsigned char* const A_ws = Ap->ws;
    typedef short bf16x8 __attribute__((ext_vector_type(8))); typedef float f32x16 __attribute__((ext_vector_type(16)));
    const bf16* HQ = (const bf16*)(A_ws + WS_R + pg8::EpiWin::O_HQ); const float* HF = (const float*)(A_ws + WS_R + pg8::EpiWin::O_HF);
    const bf16* HI = (const bf16*)(A_ws + WS_R + pg8::EpiWin::O_HI); const bf16* HG = (const bf16*)(A_ws + WS_R + pg8::EpiWin::O_HG); bf16* MIX = (bf16*)(A_ws + WS_MIX);
    const int tid = F.tid, lane = F.lane, w = F.wave, r32 = lane & 31, hi = lane >> 5, i16 = lane & 15, g1 = (lane >> 4) & 1;
    const int k = 16 * w + (lane & 15), I4 = lane >> 4;
    LAS unsigned char* const L = F.lds; LAS float* const dec = (LAS float*)(L + HG_DEC);
    const int a0 = (8 * hi + (i16 >> 2)) * HG_RS + (16 * g1 + 4 * (i16 & 3)) * 2;
    const int a0k0 = (8 * hi + (i16 >> 2)) * HG_KX0_RS + (16 * g1 + 4 * (i16 & 3)) * 2;
    const int i0 = (8 * hi + (i16 >> 2)) * 64 + (16 * g1 + 4 * (i16 & 3)) * 2;
#pragma unroll 1
    for (int u = F.bx; u < 64; u += F.G) {
        const int b = u >> 2, h = u & 3; const size_t row0 = (size_t)b * SEQ;
        const float* HFb = HF + row0 * 512 + h * 128; const bf16* HQb = HQ + row0 * 512 + h * 128; const unsigned fqo = (unsigned)(k + 16 * I4 * 512);
        const bf16* HIp0 = HI + (row0 + 16 * ((tid >> 6) & 3) + ((tid >> 2) & 15)) * 512 + h * 128 + 32 * (tid >> 8) + 8 * (tid & 3);
        const bf16* HIp1 = HI + (row0 + 16 * ((tid >> 6) & 3) + ((tid >> 2) & 15)) * 512 + h * 128 + 32 * (2 + (tid >> 8)) + 8 * (tid & 3);
        static_assert(HG_X + 64 * HG_RS == HG_ST, "X image directly below the state image");
        for (int e = tid; e < (64 * HG_RS + 128 * HG_ST_RS) / 16; e += 512) { const unsigned zu = __float_as_uint(opaque_zero()); *(LAS v4u*)(L + HG_X + e * 16) = (v4u){zu, zu, zu, zu}; }
        f32x16 S0 = zero16(), S1 = zero16();
        float xf[16]; unsigned qraw[16]; v4u inext0, inext1; v4u gt0 = {0u, 0u, 0u, 0u}, gt1 = {0u, 0u, 0u, 0u};
#pragma unroll
        for (int tt = 0; tt < 16; ++tt) { xf[tt] = HFb[fqo + tt * 512]; qraw[tt] = (unsigned)HQb[fqo + tt * 512]; }
        inext0 = *(const v4u*)HIp0; inext1 = *(const v4u*)HIp1;
#pragma unroll 1
        for (int c = 0; c < 32; ++c) {
            const size_t t0 = (size_t)64 * c;
            float e[16], G[16]; float run = 1.0f;
#pragma unroll
            for (int tt = 0; tt < 16; ++tt) { run *= xf[tt]; e[tt] = run; }
            { const float P0 = __shfl(run, lane & 15), P1 = __shfl(run, 16 + (lane & 15)), P2 = __shfl(run, 32 + (lane & 15)), P3 = __shfl(run, 48 + (lane & 15));
              const bool up = I4 >= 2;
              const float c1 = P0 * P1, T23 = P2 * P3, ptot = c1 * T23;
              const float pf = (I4 & 1) ? (up ? P2 : P0) : 1.0f;
              const float ck = up ? T23 : ptot, cq = up ? c1 : 1.0f, ckx = up ? 1.0f : c1;
              G[15] = fminf(__builtin_amdgcn_rcpf(pf * run), 1.2676506e30f);
#pragma unroll
              for (int tt = 14; tt >= 0; --tt) G[tt] = G[tt + 1] * xf[tt + 1];
              unsigned qe[8], qx[8], ke[8], k1[8], k0[8];
#pragma unroll
              for (int p2 = 0; p2 < 8; ++p2) { typedef float f32x2 __attribute__((ext_vector_type(2)));
                  const f32x2 E2 = (f32x2){e[2 * p2], e[2 * p2 + 1]} * pf, q2 = {__uint_as_float(qraw[2 * p2] << 16), __uint_as_float(qraw[2 * p2 + 1] << 16)};
                  const f32x2 vqx = q2 * E2, vqe = vqx * cq;
                  const f32x2 kk2 = (f32x2){1.0f, 1.0f} - (f32x2){xf[2 * p2], xf[2 * p2 + 1]};
                  const f32x2 vk0 = kk2 * (f32x2){G[2 * p2], G[2 * p2 + 1]}, vk1 = vk0 * ckx, vke = vk0 * ck;
                  qe[p2] = pk2(vqe[0], vqe[1]); qx[p2] = pk2(vqx[0], vqx[1]); ke[p2] = pk2(vke[0], vke[1]); k1[p2] = pk2(vk1[0], vk1[1]); k0[p2] = pk2(vk0[0], vk0[1]); }
              const float btot_p = ptot;
              LAS unsigned char* wp = L + k * HG_RS + 32 * I4;
              *(LAS v4u*)(wp + HG_QE) = (v4u){qe[0], qe[1], qe[2], qe[3]}; *(LAS v4u*)(wp + HG_QE + 16) = (v4u){qe[4], qe[5], qe[6], qe[7]};
              *(LAS v4u*)(wp + HG_QX) = (v4u){qx[0], qx[1], qx[2], qx[3]}; *(LAS v4u*)(wp + HG_QX + 16) = (v4u){qx[4], qx[5], qx[6], qx[7]};
              *(LAS v4u*)(wp + HG_KE) = (v4u){ke[0], ke[1], ke[2], ke[3]}; *(LAS v4u*)(wp + HG_KE + 16) = (v4u){ke[4], ke[5], ke[6], ke[7]};
              *(LAS v4u*)(wp + HG_KX1) = (v4u){k1[0], k1[1], k1[2], k1[3]}; *(LAS v4u*)(wp + HG_KX1 + 16) = (v4u){k1[4], k1[5], k1[6], k1[7]};
              if (I4 < 2) { LAS unsigned char* wq = L + HG_KX0 + k * HG_KX0_RS + 32 * I4; *(LAS v4u*)wq = (v4u){k0[0], k0[1], k0[2], k0[3]}; *(LAS v4u*)(wq + 16) = (v4u){k0[4], k0[5], k0[6], k0[7]}; }
              if (I4 == 0) dec[k] = btot_p;
              *(LAS v4u*)(L + HG_I + tid * 16) = inext0; *(LAS v4u*)(L + HG_I + (tid + 512) * 16) = inext1; }
            if (c + 1 < 32) {
#pragma unroll
                for (int tt = 0; tt < 16; ++tt) { xf[tt] = HFb[fqo + (unsigned)((t0 + 64 + tt) * 512)]; qraw[tt] = (unsigned)HQb[fqo + (unsigned)((t0 + 64 + tt) * 512)]; }
                inext0 = *(const v4u*)(HIp0 + (t0 + 64) * 512); inext1 = *(const v4u*)(HIp1 + (t0 + 64) * 512); }
            LDS_BARRIER();
            if (c > 0) hg_epilogue(L, tid, gt0, gt1, MIX + (row0 + t0 - 64 + (tid >> 3)) * 1024 + 256 + h * 128 + 16 * (tid & 7));
            { const bf16* gp = HG + (row0 + t0 + (tid >> 3)) * 512 + h * 128 + 16 * (tid & 7); gt0 = *(const v4u*)gp; gt1 = *(const v4u*)(gp + 8); }
#pragma unroll 1
            for (int st = w; st < 10; st += 8) {
                const int sb = st < 4 ? 0 : st < 7 ? 1 : st < 9 ? 2 : 3, tb = st < 4 ? st : st < 7 ? st - 3 : st < 9 ? st - 5 : 3;
                const int G4 = lane >> 4;
                LAS unsigned char* ap = (tb < 2) ? (L + HG_KX0 + (8 * G4 + (i16 >> 2)) * HG_KX0_RS + (16 * sb + 4 * (i16 & 3)) * 2) : (L + HG_KX1 + (8 * G4 + (i16 >> 2)) * HG_RS + (16 * sb + 4 * (i16 & 3)) * 2);
                const int ars = (tb < 2) ? HG_KX0_RS : HG_RS;
                LAS unsigned char* bp = L + HG_QX + (8 * G4 + (i16 >> 2)) * HG_RS + (16 * tb + 4 * (i16 & 3)) * 2;
                f32x4 xa = {0.f, 0.f, 0.f, 0.f};
#pragma unroll
                for (int ks = 0; ks < 4; ++ks) { const hg_s16x4 al = hg_tr(ap + ks * 32 * ars), ah = hg_tr(ap + ks * 32 * ars + 4 * ars), bl_ = hg_tr(bp + ks * 32 * HG_RS), bh_ = hg_tr(bp + ks * 32 * HG_RS + 4 * HG_RS);
                    const bf16x8 af = __builtin_shufflevector(al, ah, 0, 1, 2, 3, 4, 5, 6, 7), bfr = __builtin_shufflevector(bl_, bh_, 0, 1, 2, 3, 4, 5, 6, 7);
                    xa = __builtin_amdgcn_mfma_f32_16x16x32_bf16(af, bfr, xa, 0, 0, 0); }
                if (sb == tb) {
#pragma unroll
                    for (int r = 0; r < 4; ++r) if (4 * G4 + r > i16) xa[r] = 0.f; }
                typedef unsigned u32x2_t __attribute__((ext_vector_type(2)));
                *(LAS u32x2_t*)(L + HG_X + (16 * tb + i16) * HG_RS + (16 * sb + 4 * G4) * 2) = (u32x2_t){pk2(xa[0], xa[1]), pk2(xa[2], xa[3])};
            }
            f32x16 oacc = zero16();
            bf16x8 ifr[4];
            { const int vb = w & 3, hf = w >> 2;
#pragma unroll
              for (int ss = 0; ss < 4; ++ss) { const hg_s16x4 lo = hg_tr(L + HG_I + (vb * 4 + ss) * 1024 + i0), hh = hg_tr(L + HG_I + (vb * 4 + ss) * 1024 + i0 + 256); ifr[ss] = __builtin_shufflevector(lo, hh, 0, 1, 2, 3, 4, 5, 6, 7); }
              LAS unsigned char* qp = L + HG_QE + a0 + 64 * hf; LAS unsigned char* sp = L + HG_ST + (32 * vb + r32) * HG_ST_RS + 16 * hi;
#pragma unroll
              for (int ks = 0; ks < 8; ++ks) { const hg_s16x4 al = hg_tr(qp + ks * 16 * HG_RS), ah = hg_tr(qp + ks * 16 * HG_RS + 4 * HG_RS);
                  const bf16x8 af = __builtin_shufflevector(al, ah, 0, 1, 2, 3, 4, 5, 6, 7), bfr = *(const LAS bf16x8*)(sp + 32 * ks);
                  oacc = __builtin_amdgcn_mfma_f32_32x32x16_bf16(af, bfr, oacc, 0, 0, 0); }
              LAS unsigned char* kp = L + HG_KE + (64 * hf + r32) * HG_RS + 16 * hi;
#pragma unroll
              for (int g = 0; g < 4; ++g) { const f32x4 d0 = *(const LAS f32x4*)(dec + 64 * hf + 8 * g + 4 * hi), d1 = *(const LAS f32x4*)(dec + 64 * hf + 32 + 8 * g + 4 * hi);
#pragma unroll
                  for (int e = 0; e < 4; ++e) { S0[4 * g + e] *= d0[e]; S1[4 * g + e] *= d1[e]; } }
#pragma unroll
              for (int ss = 0; ss < 4; ++ss) { const bf16x8 af0 = *(const LAS bf16x8*)(kp + 32 * ss), af1 = *(const LAS bf16x8*)(kp + 32 * HG_RS + 32 * ss);
                  S0 = __builtin_amdgcn_mfma_f32_32x32x16_bf16(af0, ifr[ss], S0, 0, 0, 0); S1 = __builtin_amdgcn_mfma_f32_32x32x16_bf16(af1, ifr[ss], S1, 0, 0, 0); }
            }
            LDS_BARRIER();
            { const int hf = w >> 2; LAS unsigned char* xq = L + HG_X + (32 * hf + r32) * HG_RS + 16 * hi;
#pragma unroll
              for (int ss = 0; ss < 4; ++ss) if (ss < 2 * hf + 2) { const bf16x8 af = *(const LAS bf16x8*)(xq + 32 * ss); oacc = __builtin_amdgcn_mfma_f32_32x32x16_bf16(af, ifr[ss], oacc, 0, 0, 0); } }
            { const int vb = w & 3, hf = w >> 2;
              LAS unsigned char* ob = L + HG_OB + (32 * vb + r32) * 2;
#pragma unroll
              for (int r = 0; r < 16; ++r) *(LAS unsigned short*)(ob + (32 * hf + crow16(r, hi)) * HG_OB_RS) = (unsigned short)f2bf(oacc[r]);
              LAS unsigned char* sw = L + HG_ST + (32 * vb + r32) * HG_ST_RS + (64 * hf + 4 * hi) * 2;
#pragma unroll
              for (int g = 0; g < 4; ++g) { typedef unsigned u32x2_t __attribute__((ext_vector_type(2)));
                  *(LAS u32x2_t*)(sw + 16 * g) = (u32x2_t){pk2(S0[4 * g], S0[4 * g + 1]), pk2(S0[4 * g + 2], S0[4 * g + 3])};
                  *(LAS u32x2_t*)(sw + 64 + 16 * g) = (u32x2_t){pk2(S1[4 * g], S1[4 * g + 1]), pk2(S1[4 * g + 2], S1[4 * g + 3])}; } }
        }
        LDS_BARRIER();
        hg_epilogue(L, tid, gt0, gt1, MIX + (row0 + (size_t)31 * 64 + (tid >> 3)) * 1024 + 256 + h * 128 + 16 * (tid & 7));
        __syncthreads();
    }
}

__global__ void __launch_bounds__(NWAVES * 64, 2) mega_fwd(Args args) {
    extern __shared__ __attribute__((aligned(16))) unsigned char lds[];
    Frame F;
    F.lds = (LAS unsigned char*)lds; F.MISC = (volatile LAS unsigned*)(F.lds + MISC_OFF);
    F.tid = threadIdx.x; F.lane = F.tid & 63; F.wave = __builtin_amdgcn_readfirstlane(F.tid >> 6); F.G = gridDim.x;
    F.ctl = (unsigned*)(kargs()->ws + WS_CTL);
    for (int u = F.tid; u < (LDS_BYTES - LDSCTL_OFF) / 4; u += NWAVES * 64) ((LAS unsigned*)(F.lds + LDSCTL_OFF))[u] = 0u;
    __syncthreads();
    XcdBarrier bar = xcd_barrier_post(F.ctl + CW_BAR, F.MISC + 8);
#define GRID_BAR() do { XcdBarrier b_ = bar; asm volatile("" : "+s"(b_.bar), "+s"(b_.x)); xcd_barrier(b_); } while (0)

#ifndef REP_PRO
#define REP_PRO 1
#endif
#ifndef REP_GU
#define REP_GU 1
#endif
#ifndef REP_WIN
#define REP_WIN 1
#endif
#ifndef REP_MIX
#define REP_MIX 1
#endif
#ifndef REP_HGRN
#define REP_HGRN 1
#endif
#ifndef REP_ATTN
#define REP_ATTN 1
#endif
#ifndef REP_S5
#define REP_S5 1
#endif
#pragma unroll 1
    for (int j = -1; j < 2 * DEPTH; ++j) {
        const int l = j < 0 ? 0 : j >> 1, ffn = j < 0 ? 0 : j & 1;
        if (j >= 0) {
#pragma unroll 1
        for (int rep = 0; rep < REP_GU; ++rep)
        {
            const KArgs ka = kargs(); unsigned char* const ws = ka->ws; unsigned char* const wl = ws + WS_W + (size_t)l * W_LAYER; bf16* const XB = (bf16*)(ws + WS_XB); pg8::ssq_t* const SSQ7 = (pg8::ssq_t*)(ws + WS_SSQ7); bf16* const ACT = (bf16*)(ws + WS_R); bf16* const MIX = (bf16*)(ws + WS_MIX); bf16* const ZB = (bf16*)(ws + WS_ZB); float* const AF = (float*)(ws + WS_AF); (void)wl; (void)XB; (void)SSQ7; (void)ACT; (void)MIX; (void)ZB; (void)AF;
            pg8::Gemm g{XB, (const bf16*)(wl + (ffn ? OW_GU2 : OW_GU1)), M, NGU, DM}; pg8::StaticOrder S; F.relaunder(); S.init(M, NGU, F.G, F.bx);
            pg8::EpiSwiglu E{ACT, SSQ7 + (size_t)(ffn ? 2 + 3 * l : 3 * l) * M};
            pg8::gemm_phase<pg8::EpiSwiglu, pg8::StaticOrder, true, true>(F.lds + RING_OFF, g, S, E);
            GRID_BAR(); }
#ifndef REP_DN
#define REP_DN 1
#endif
#pragma unroll 1
        for (int rep = 0; rep < REP_DN; ++rep)
        {
            const KArgs ka = kargs(); unsigned char* const ws = ka->ws; unsigned char* const wl = ws + WS_W + (size_t)l * W_LAYER; bf16* const XB = (bf16*)(ws + WS_XB); pg8::ssq_t* const SSQ7 = (pg8::ssq_t*)(ws + WS_SSQ7); bf16* const ACT = (bf16*)(ws + WS_R); bf16* const MIX = (bf16*)(ws + WS_MIX); bf16* const ZB = (bf16*)(ws + WS_ZB); float* const AF = (float*)(ws + WS_AF); (void)wl; (void)XB; (void)SSQ7; (void)ACT; (void)MIX; (void)ZB; (void)AF;
            pg8::Gemm g{ACT, (const bf16*)(wl + (ffn ? OW_D2 : OW_D1)), M, DM, DFF}; pg8::StaticOrder S; F.relaunder(); S.init(M, DM, F.G, F.bx);
            pg8::EpiResid E{XB, (j == 2 * DEPTH - 1 && rep == REP_DN - 1) ? ka->out : (float*)nullptr, SSQ7 + (size_t)(rep == REP_DN - 1 ? (ffn ? (3 + 3 * l) % 7 : 1 + 3 * l) : 7) * M, 0.5f / REP_DN};
            pg8::gemm_phase<pg8::EpiResid, pg8::StaticOrder, true, true>(F.lds + RING_OFF, g, S, E);
            GRID_BAR(); }
        }
        if (ffn == 0) {
            if (j >= 0) {
#pragma unroll 1
            for (int rep = 0; rep < REP_WIN; ++rep)
            {
            const KArgs ka = kargs(); unsigned char* const ws = ka->ws; unsigned char* const wl = ws + WS_W + (size_t)l * W_LAYER; bf16* const XB = (bf16*)(ws + WS_XB); pg8::ssq_t* const SSQ7 = (pg8::ssq_t*)(ws + WS_SSQ7); bf16* const ACT = (bf16*)(ws + WS_R); bf16* const MIX = (bf16*)(ws + WS_MIX); bf16* const ZB = (bf16*)(ws + WS_ZB); float* const AF = (float*)(ws + WS_AF); (void)wl; (void)XB; (void)SSQ7; (void)ACT; (void)MIX; (void)ZB; (void)AF;
                pg8::Gemm g{XB, (const bf16*)(wl + OW_IN), M, NIN, DM}; pg8::StaticOrder S; F.relaunder(); S.init(M, NIN, F.G, F.bx);
                pg8::EpiWin E{ws + WS_R, SSQ7 + (size_t)(1 + 3 * l) * M, ka->in[8] + l * 64, ka->in[9] + l * 64, AF, (const float*)(ws + WS_LBT) + l * 512, ka->in[11] + l * 512};
                pg8::gemm_phase<pg8::EpiWin, pg8::StaticOrder, true, true>(F.lds + RING_OFF, g, S, E);
                GRID_BAR(); }
#pragma unroll 1
            for (int rm = 0; rm < REP_MIX; ++rm) {
            if (rm > 0) GRID_BAR();
#ifdef NAIVE_HGRN
            naive_hgrn(F, l);
#else
            for (int r2 = 0; r2 < REP_HGRN; ++r2) fast_hgrn(F, l);
#endif
#ifdef NAIVE_ATTN
            naive_attn(F, l);
#else
            for (int r2 = 0; r2 < REP_ATTN; ++r2) fast_attn(F, (char*)lds, l);
#endif
#ifdef NAIVE_S5
            naive_s5(F, l);
#else
            for (int r2 = 0; r2 < REP_S5; ++r2) fast_s5(F, l);
#endif
            }
            }
            if (j <= 0) { F.relaunder(); const bool sub = j == 0 && F.G == 256; if (!sub || F.bx >= 64) conv_layer(F, j + 1, sub ? F.bx - 64 : F.bx, sub ? 192 : F.G); }
            if (j < 0) p0_prologue(F);
            GRID_BAR();
            if (j >= 0) {
            {
            const KArgs ka = kargs(); unsigned char* const ws = ka->ws; unsigned char* const wl = ws + WS_W + (size_t)l * W_LAYER; bf16* const XB = (bf16*)(ws + WS_XB); pg8::ssq_t* const SSQ7 = (pg8::ssq_t*)(ws + WS_SSQ7); bf16* const ACT = (bf16*)(ws + WS_R); bf16* const MIX = (bf16*)(ws + WS_MIX); bf16* const ZB = (bf16*)(ws + WS_ZB); float* const AF = (float*)(ws + WS_AF); (void)wl; (void)XB; (void)SSQ7; (void)ACT; (void)MIX; (void)ZB; (void)AF;
                pg8::Gemm g{ZB, (const bf16*)(wl + OW_GLU), M, 256, 256}; pg8::StaticOrder S; F.relaunder(); S.init(M, 256, F.G, F.bx);
                pg8::EpiGlu E{ZB, ka->in[21] + l * 256, MIX};
                pg8::gemm_phase<pg8::EpiGlu, pg8::StaticOrder, true, true>(F.lds + RING_OFF, g, S, E);
                GRID_BAR(); }
            {
            const KArgs ka = kargs(); unsigned char* const ws = ka->ws; unsigned char* const wl = ws + WS_W + (size_t)l * W_LAYER; bf16* const XB = (bf16*)(ws + WS_XB); pg8::ssq_t* const SSQ7 = (pg8::ssq_t*)(ws + WS_SSQ7); bf16* const ACT = (bf16*)(ws + WS_R); bf16* const MIX = (bf16*)(ws + WS_MIX); bf16* const ZB = (bf16*)(ws + WS_ZB); float* const AF = (float*)(ws + WS_AF); (void)wl; (void)XB; (void)SSQ7; (void)ACT; (void)MIX; (void)ZB; (void)AF;
                pg8::Gemm g{MIX, (const bf16*)(wl + OW_OUT), M, DM, DM}; pg8::StaticOrder S; F.relaunder(); S.init(M, DM, F.G, F.bx);
                pg8::EpiResid E{XB, (float*)nullptr, SSQ7 + (size_t)(2 + 3 * l) * M, 1.0f};
                pg8::gemm_phase<pg8::EpiResid, pg8::StaticOrder, true, true>(F.lds + RING_OFF, g, S, E);
                GRID_BAR(); }
            }
        }
    }
}

extern "C" void kernel_launch(void* const* d_in, const int* in_sizes, int n_in, void* d_out, int out_size, void* d_ws, size_t ws_size, hipStream_t stream) {
    static int grid = 0;
    if (grid == 0) {
        if (n_in != 27 || in_sizes[0] != M * DM || out_size != M * DM || ws_size < WS_END) { fprintf(stderr, "kernel_launch: unexpected shapes: n_in %d in0 %d out %d ws %zu (need %zu)\n", n_in, n_in > 0 ? in_sizes[0] : -1, out_size, ws_size, (size_t)WS_END); grid = -1; return; }
        int dev = 0, cus = 0, per_cu = 0;
        if (hipGetDevice(&dev) != hipSuccess || hipDeviceGetAttribute(&cus, hipDeviceAttributeMultiprocessorCount, dev) != hipSuccess) { grid = -1; return; }
        if (hipFuncSetAttribute((const void*)mega_fwd, hipFuncAttributeMaxDynamicSharedMemorySize, LDS_BYTES) != hipSuccess) { fprintf(stderr, "kernel_launch: hipFuncSetAttribute failed\n"); grid = -1; return; }
        if (hipOccupancyMaxActiveBlocksPerMultiprocessor(&per_cu, (const void*)mega_fwd, NWAVES * 64, LDS_BYTES) != hipSuccess || per_cu < 1) fprintf(stderr, "kernel_launch: occupancy query says %d\n", per_cu);
        (void)hipGetLastError();
        grid = cus;
    }
    if (grid < 0) return;
    if (hipMemsetAsync((char*)d_ws + WS_CTL, 0, CTL_ZERO_BYTES, stream) != hipSuccess) return;
    Args a{};
    for (int i = 0; i < 27; ++i) a.in[i] = (const float*)d_in[i];
    a.out = (float*)d_out; a.ws = (unsigned char*)d_ws;
    hipLaunchKernelGGL(mega_fwd, dim3(grid), dim3(NWAVES * 64), LDS_BYTES, stream, a);
}
```
